# Optimizing an MI355X kernel written in HIP

```python
import jax, jax.numpy as jnp
from jax import lax
import numpy as np

D_MODEL = 2048
BATCH = 1
SEQ = 8192
DEPTH = 1
DEC_BATCH = 128
DEC_SEQ = 8
PAST_LEN = 16384
PAGE_SIZE = 128

GLA_HEADS = 4
GLA_DK = D_MODEL // (2 * GLA_HEADS)
GLA_DV = D_MODEL // GLA_HEADS
GLA_RANK = 16
GLA_GATE_NORM = 16.0
GLA_CHUNK = 64
SWA_HEAD_DIM = 64
SWA_HEADS = D_MODEL // SWA_HEAD_DIM
SWA_KV_HEADS = SWA_HEADS // 4
SWA_GROUP = SWA_HEADS // SWA_KV_HEADS
WINDOW = 128
D_FF = 256 * ((8 * D_MODEL // 3 + 255) // 256)
ALPHA = (2.0 * DEPTH) ** 0.25
BETA = (8.0 * DEPTH) ** -0.25
LN_EPS = 1e-5
RMS_EPS = 1e-6
NEG_INF = -1e30

SPLIT_SIZES = (GLA_HEADS * GLA_DK, GLA_HEADS * GLA_DK, GLA_HEADS * GLA_DV, GLA_HEADS * GLA_DV, GLA_RANK,
               SWA_HEADS * SWA_HEAD_DIM, SWA_KV_HEADS * SWA_HEAD_DIM, SWA_KV_HEADS * SWA_HEAD_DIM,
               D_MODEL, D_MODEL)
D_IN = sum(SPLIT_SIZES)

kernel_name = 'hybrid_gla_swa_sink_macaron_deepnorm_step'


def layer_norm(x, w, b):
    xf = x.astype(jnp.float32)
    mu = jnp.mean(xf, axis=-1, keepdims=True)
    var = jnp.mean(jnp.square(xf - mu), axis=-1, keepdims=True)
    return ((xf - mu) * lax.rsqrt(var + LN_EPS) * w.astype(jnp.float32) + b.astype(jnp.float32)).astype(x.dtype)


def swiglu_ffn(x, w_in, w_out):
    gate, up = jnp.split(x @ w_in, 2, axis=-1)
    return (jax.nn.silu(gate) * up) @ w_out


def alibi_slopes():
    return 2.0 ** (-8.0 * jnp.arange(1, SWA_HEADS + 1, dtype=jnp.float32) / SWA_HEADS)


def gla_chunked(q, k, v, log_a, s0):
    B, T = q.shape[:2]
    C = GLA_CHUNK if T % GLA_CHUNK == 0 else T
    n = T // C

    def to_chunks(a):
        return a.reshape(B, n, C, a.shape[2], a.shape[3]).transpose(1, 0, 3, 2, 4)

    qc, kc, vc, gc = to_chunks(q), to_chunks(k), to_chunks(v), to_chunks(log_a)
    causal = jnp.tril(jnp.ones((C, C), dtype=bool))[:, :, None]

    def step(S, inp):
        qb, kb, vb, gb = inp
        qf, kf, vf = qb.astype(jnp.float32), kb.astype(jnp.float32), vb.astype(jnp.float32)
        b = jnp.cumsum(gb.astype(jnp.float32), axis=2)
        inter = jnp.einsum('bhtk,bhkv->bhtv', qf * jnp.exp(b), S)
        rel = jnp.where(causal, b[:, :, :, None, :] - b[:, :, None, :, :], -jnp.inf)
        scores = jnp.einsum('bhtk,bhsk,bhtsk->bhts', qf, kf, jnp.exp(rel))
        intra = jnp.einsum('bhts,bhsv->bhtv', scores, vf)
        bl = b[:, :, -1:, :]
        S_new = jnp.exp(bl[:, :, 0, :, None]) * S + jnp.einsum('bhsk,bhsv->bhkv', kf * jnp.exp(bl - b), vf)
        return S_new, inter + intra

    S_fin, o = lax.scan(step, s0.astype(jnp.float32), (qc, kc, vc, gc))
    o = o.transpose(1, 0, 3, 2, 4).reshape(B, T, q.shape[2], v.shape[3])
    return o, S_fin


def swa_block_attend(q, k, v, q_pos, k_pos, sinks):
    s = jnp.einsum('bnqhgd,bnkhd->bnhgqk', q, k).astype(jnp.float32) * (SWA_HEAD_DIM ** -0.5)
    dist = q_pos[:, :, None] - k_pos[:, None, :]
    valid = (dist >= 0) & (dist < WINDOW) & (k_pos[:, None, :] >= 0)
    slopes = alibi_slopes().reshape(SWA_KV_HEADS, SWA_GROUP, 1, 1)
    s = s - slopes * dist.astype(jnp.float32)[:, None, None]
    s = jnp.where(valid[:, None, None], s, NEG_INF)
    sink = jnp.broadcast_to(sinks.astype(jnp.float32).reshape(SWA_KV_HEADS, SWA_GROUP, 1, 1), s.shape[:-1] + (1,))
    p = jax.nn.softmax(jnp.concatenate([s, sink], axis=-1), axis=-1)[..., :-1]
    return jnp.einsum('bnhgqk,bnkhd->bnqhgd', p.astype(v.dtype), v)


def token_mixers(h, gla_s0, k_buf, v_buf, w_in, b_in, w_gla_gate, b_gla_gate, gla_norm_w, swa_sinks,
                 w_br_gla, w_br_swa, w_o):
    B, T, _ = h.shape
    z = h @ w_in + b_in
    split_idx = np.cumsum(SPLIT_SIZES)[:-1].tolist()
    q_g, k_g, v_g, g_g, r_g, q_s, k_s, v_s, gate_gla, gate_swa = jnp.split(z, split_idx, axis=-1)

    q_g = q_g.reshape(B, T, GLA_HEADS, GLA_DK) * (GLA_DK ** -0.5)
    k_g = k_g.reshape(B, T, GLA_HEADS, GLA_DK)
    v_g = v_g.reshape(B, T, GLA_HEADS, GLA_DV)
    log_a = jax.nn.log_sigmoid((r_g @ w_gla_gate + b_gla_gate).astype(jnp.float32)) / GLA_GATE_NORM
    log_a = log_a.reshape(B, T, GLA_HEADS, GLA_DK)
    s0 = jnp.zeros((B, GLA_HEADS, GLA_DK, GLA_DV), jnp.float32) if gla_s0 is None else gla_s0
    o_g, gla_state = gla_chunked(q_g, k_g, v_g, log_a, s0)
    of = o_g.astype(jnp.float32)
    of = of * lax.rsqrt(jnp.mean(jnp.square(of), axis=-1, keepdims=True) + RMS_EPS) * gla_norm_w.astype(jnp.float32)
    o_g = of.reshape(B, T, GLA_HEADS * GLA_DV).astype(h.dtype) * jax.nn.silu(g_g)
    u_gla = o_g @ w_br_gla
    gla_state = gla_state.astype(s0.dtype)

    q_s = q_s.reshape(B, T, SWA_KV_HEADS, SWA_GROUP, SWA_HEAD_DIM)
    k_s = k_s.reshape(B, T, SWA_KV_HEADS, SWA_HEAD_DIM)
    v_s = v_s.reshape(B, T, SWA_KV_HEADS, SWA_HEAD_DIM)
    if k_buf is None:
        n = T // WINDOW
        zpad = jnp.zeros((B, WINDOW, SWA_KV_HEADS, SWA_HEAD_DIM), k_s.dtype)
        kb = jnp.concatenate([zpad, k_s], axis=1).reshape(B, n + 1, WINDOW, SWA_KV_HEADS, SWA_HEAD_DIM)
        vb = jnp.concatenate([zpad, v_s], axis=1).reshape(B, n + 1, WINDOW, SWA_KV_HEADS, SWA_HEAD_DIM)
        keys = jnp.concatenate([kb[:, :-1], kb[:, 1:]], axis=2)
        vals = jnp.concatenate([vb[:, :-1], vb[:, 1:]], axis=2)
        blk = jnp.arange(n, dtype=jnp.int32)[:, None]
        q_pos = blk * WINDOW + jnp.arange(WINDOW, dtype=jnp.int32)[None]
        k_pos = (blk - 1) * WINDOW + jnp.arange(2 * WINDOW, dtype=jnp.int32)[None]
        o_s = swa_block_attend(q_s.reshape(B, n, WINDOW, SWA_KV_HEADS, SWA_GROUP, SWA_HEAD_DIM),
                               keys, vals, q_pos, k_pos, swa_sinks)
        k_new = k_s[:, T - WINDOW:]
        v_new = v_s[:, T - WINDOW:]
    else:
        keys = jnp.concatenate([k_buf.astype(k_s.dtype), k_s], axis=1)
        vals = jnp.concatenate([v_buf.astype(v_s.dtype), v_s], axis=1)
        q_pos = (PAST_LEN + jnp.arange(T, dtype=jnp.int32))[None]
        k_pos = (PAST_LEN - WINDOW + jnp.arange(WINDOW + T, dtype=jnp.int32))[None]
        o_s = swa_block_attend(q_s[:, None], keys[:, None], vals[:, None], q_pos, k_pos, swa_sinks)
        k_new = keys[:, T:]
        v_new = vals[:, T:]
    o_s = o_s.reshape(B, T, SWA_HEADS * SWA_HEAD_DIM)
    u_swa = o_s @ w_br_swa

    merged = jax.nn.sigmoid(gate_gla) * u_gla + jax.nn.sigmoid(gate_swa) * u_swa
    return merged @ w_o, gla_state, k_new, v_new


def decoder_layer(x, gla_s0, k_buf, v_buf, p):
    x = layer_norm(ALPHA * x + 0.5 * swiglu_ffn(x, p['w_ffn1_in'], p['w_ffn1_out']), p['ln_ffn1_w'], p['ln_ffn1_b'])
    mix, s_new, k_new, v_new = token_mixers(x, gla_s0, k_buf, v_buf, p['w_in'], p['b_in'], p['w_gla_gate'],
                                            p['b_gla_gate'], p['gla_norm_w'], p['swa_sinks'],
                                            p['w_br_gla'], p['w_br_swa'], p['w_o'])
    x = layer_norm(ALPHA * x + mix, p['ln_mix_w'], p['ln_mix_b'])
    x = layer_norm(ALPHA * x + 0.5 * swiglu_ffn(x, p['w_ffn2_in'], p['w_ffn2_out']), p['ln_ffn2_w'], p['ln_ffn2_b'])
    return x, s_new, k_new, v_new


def setup_inputs(seed: int = 0) -> dict:
    key = jax.random.key(seed)
    ks = jax.random.split(key, 24)
    L, D = DEPTH, D_MODEL

    def nrm(k, shape, scale):
        return jax.random.normal(k, shape, jnp.float32) * scale

    return {
        'x_prompt': nrm(ks[0], (BATCH, SEQ, D), 1.0),
        'x_sample': nrm(ks[1], (DEC_BATCH, DEC_SEQ, D), 1.0),
        'state_gla': nrm(ks[2], (L, DEC_BATCH, GLA_HEADS, GLA_DK, GLA_DV), 0.5),
        'cache_swa_k': nrm(ks[3], (L, DEC_BATCH, WINDOW, SWA_KV_HEADS, SWA_HEAD_DIM), 1.0),
        'cache_swa_v': nrm(ks[4], (L, DEC_BATCH, WINDOW, SWA_KV_HEADS, SWA_HEAD_DIM), 1.0),
        'w_ffn1_in': nrm(ks[5], (L, D, 2 * D_FF), D ** -0.5),
        'w_ffn1_out': nrm(ks[6], (L, D_FF, D), BETA * D_FF ** -0.5),
        'ln_ffn1_w': 1.0 + nrm(ks[7], (L, D), 0.02),
        'ln_ffn1_b': nrm(ks[8], (L, D), 0.02),
        'w_in': nrm(ks[9], (L, D, D_IN), D ** -0.5),
        'b_in': nrm(ks[10], (L, D_IN), 0.02),
        'w_gla_gate': nrm(ks[11], (L, GLA_RANK, GLA_HEADS * GLA_DK), GLA_RANK ** -0.5),
        'b_gla_gate': nrm(ks[12], (L, GLA_HEADS * GLA_DK), 0.1),
        'gla_norm_w': 1.0 + nrm(ks[13], (L, GLA_DV), 0.02),
        'swa_sinks': nrm(ks[14], (L, SWA_HEADS), 0.5),
        'w_br_gla': nrm(ks[15], (L, GLA_HEADS * GLA_DV, D), BETA * (GLA_HEADS * GLA_DV) ** -0.5),
        'w_br_swa': nrm(ks[16], (L, SWA_HEADS * SWA_HEAD_DIM, D), BETA * (SWA_HEADS * SWA_HEAD_DIM) ** -0.5),
        'w_o': nrm(ks[17], (L, D, D), BETA * D ** -0.5),
        'ln_mix_w': 1.0 + nrm(ks[18], (L, D), 0.02),
        'ln_mix_b': nrm(ks[19], (L, D), 0.02),
        'w_ffn2_in': nrm(ks[20], (L, D, 2 * D_FF), D ** -0.5),
        'w_ffn2_out': nrm(ks[21], (L, D_FF, D), BETA * D_FF ** -0.5),
        'ln_ffn2_w': 1.0 + nrm(ks[22], (L, D), 0.02),
        'ln_ffn2_b': nrm(ks[23], (L, D), 0.02),
    }


def reference(x_prompt, x_sample, state_gla, cache_swa_k, cache_swa_v, w_ffn1_in, w_ffn1_out, ln_ffn1_w,
              ln_ffn1_b, w_in, b_in, w_gla_gate, b_gla_gate, gla_norm_w, swa_sinks, w_br_gla, w_br_swa, w_o,
              ln_mix_w, ln_mix_b, w_ffn2_in, w_ffn2_out, ln_ffn2_w, ln_ffn2_b):
    hp, hs = x_prompt, x_sample
    sp_list, kp_list, vp_list, ss_list, ks_list, vs_list = [], [], [], [], [], []
    for l in range(DEPTH):
        p = {'w_ffn1_in': w_ffn1_in[l], 'w_ffn1_out': w_ffn1_out[l], 'ln_ffn1_w': ln_ffn1_w[l],
             'ln_ffn1_b': ln_ffn1_b[l], 'w_in': w_in[l], 'b_in': b_in[l], 'w_gla_gate': w_gla_gate[l],
             'b_gla_gate': b_gla_gate[l], 'gla_norm_w': gla_norm_w[l], 'swa_sinks': swa_sinks[l],
             'w_br_gla': w_br_gla[l], 'w_br_swa': w_br_swa[l], 'w_o': w_o[l], 'ln_mix_w': ln_mix_w[l],
             'ln_mix_b': ln_mix_b[l], 'w_ffn2_in': w_ffn2_in[l], 'w_ffn2_out': w_ffn2_out[l],
             'ln_ffn2_w': ln_ffn2_w[l], 'ln_ffn2_b': ln_ffn2_b[l]}
        hp, sp, kp, vp = decoder_layer(hp, None, None, None, p)
        hs, ss, ksn, vsn = decoder_layer(hs, state_gla[l], cache_swa_k[l], cache_swa_v[l], p)
        sp_list.append(sp); kp_list.append(kp); vp_list.append(vp)
        ss_list.append(ss); ks_list.append(ksn); vs_list.append(vsn)
    return (hp, hs, jnp.stack(sp_list), jnp.stack(kp_list), jnp.stack(vp_list),
            jnp.stack(ss_list), jnp.stack(ks_list), jnp.stack(vs_list))
```

```cpp
#include <hip/hip_runtime.h>
#include <hip/hip_cooperative_groups.h>
#include <cstdio>
#include <cstdint>
namespace cg = cooperative_groups;
namespace pg8 {
#define PG8_LAS __attribute__((address_space(3)))
typedef unsigned short bf16_t;
typedef short bf16x8 __attribute__((ext_vector_type(8)));
typedef float f32x4 __attribute__((ext_vector_type(4)));
typedef unsigned u32x4 __attribute__((ext_vector_type(4)));
constexpr int BM = 256, BK = 64, HALF = 128, HTB = HALF * BK * 2  , STAGE_BYTES = 8 * HTB, NXCD = 8, WGM = 8;

__host__ __device__ __forceinline__ int lds_byte(int r, int c) { const int st = (r >> 4) * 2 + (c >> 5), rr = r & 15, cc = c & 31, ob = rr * 64 + cc * 2; return st * 1024 + (ob ^ (((ob >> 9) & 1) << 5)); }
__host__ __device__ __forceinline__ void stage_rc(int b, int& R, int& C) { const int st = b / 1024, sb = b % 1024, swz = sb ^ (((sb >> 9) & 1) << 5); R = (st >> 1) * 16 + swz / 64; C = (st & 1) * 32 + (swz % 64) / 2; }
__host__ __device__ __forceinline__ int perm32(int rho) { const int n = rho >> 4, i = rho & 15; return 8 * (i >> 2) + 4 * n + (i & 3); }

struct Unit { int pm, pn; };
struct Gemm { const bf16_t* A; const bf16_t* Bt; int M, N, K; };

struct StaticOrder {
    int nM, nN, nwg, G, c;
    __host__ __device__ void init(int M, int N, int G_, int c_) { nM = M / BM; nN = N / BM; nwg = nM * nN; G = G_; c = c_; }
    __host__ __device__ bool next(int i, Unit& u) const {
        const long L = (long)i * G + c; if (L >= nwg) return false;
        int wgid = (int)L; { const int q = nwg / NXCD, r = nwg % NXCD, xcd = wgid % NXCD, off = wgid / NXCD; wgid = (xcd < r ? xcd * (q + 1) : r * (q + 1) + (xcd - r) * q) + off; }
        const int nig = WGM * nN, gid = wgid / nig, fm = gid * WGM, gsz = (nM - fm) < WGM ? (nM - fm) : WGM;
        u.pm = fm + ((wgid % nig) % gsz); u.pn = (wgid % nig) / gsz; return true;
    }
    __device__ __forceinline__ void a_ready(const Unit&) const {}
    __device__ __forceinline__ void done(const Unit&) const {}
};

__device__ __forceinline__ unsigned cvt_pk_bf16(float lo, float hi) { unsigned r; asm volatile("v_cvt_pk_bf16_f32 %0, %1, %2" : "=v"(r) : "v"(lo), "v"(hi)); return r; }
typedef unsigned u32x2 __attribute__((ext_vector_type(2)));
__device__ __forceinline__ float bf_lo(unsigned w) { return __uint_as_float(w << 16); }
__device__ __forceinline__ float bf_hi(unsigned w) { return __uint_as_float(w & 0xffff0000u); }
__device__ __forceinline__ float fast_sigmoid(float x) { return __builtin_amdgcn_rcpf(1.0f + __builtin_amdgcn_exp2f(-1.44269504f * x)); }
__device__ __forceinline__ float fast_silu(float x) { return x * fast_sigmoid(x); }

struct EpiSwiglu {
    static constexpr bool PERM = true, AFTER_DRAIN = false;
    bf16_t* H; int ldh;
    __device__ __forceinline__ void operator()(const f32x4 (&acc)[2][2][4][2], const Unit& u, int wr, int wc, int fr, int fq) const {
        const int row0 = u.pm * BM + wr * 64 + fr, col0 = u.pn * 128 + wc * 32 + 8 * fq;
#pragma unroll
        for (int ai = 0; ai < 2; ++ai)
#pragma unroll
            for (int m = 0; m < 4; ++m) {
                bf16_t* rowp = H + (size_t)(row0 + ai * HALF + m * 16) * ldh + col0;
                const f32x4 g0 = acc[ai][0][m][0], g1 = acc[ai][0][m][1], u0 = acc[ai][1][m][0], u1 = acc[ai][1][m][1];
                float h[8];
#pragma unroll
                for (int j = 0; j < 4; ++j) { h[j] = fast_silu(g0[j]) * u0[j]; h[4 + j] = fast_silu(g1[j]) * u1[j]; }
                u32x4 w; w.x = cvt_pk_bf16(h[0], h[1]); w.y = cvt_pk_bf16(h[2], h[3]); w.z = cvt_pk_bf16(h[4], h[5]); w.w = cvt_pk_bf16(h[6], h[7]);
                *(u32x4*)rowp = w;
            }
    }
};

struct EpiRes {
    static constexpr bool PERM = false, AFTER_DRAIN = false;
    const float* resA; const float* resB; float* out; float alpha, scale;
    __device__ __forceinline__ void operator()(const f32x4 (&acc)[2][2][4][2], const Unit& u, int wr, int wc, int fr, int fq) const {
        const int row0 = u.pm * BM + wr * 64 + fr, col0 = u.pn * BM + wc * 32 + 4 * fq;
        const float* rbase = (u.pm < 32) ? resA + (size_t)row0 * 2048 : resB + (size_t)(row0 - 8192) * 2048;
#pragma unroll
        for (int ai = 0; ai < 2; ++ai)
#pragma unroll
            for (int m = 0; m < 4; ++m) {
                const size_t roff = (size_t)(ai * HALF + m * 16) * 2048 + col0;
                float* op = out + (size_t)row0 * 2048 + roff; const float* rp = rbase + roff;
#pragma unroll
                for (int bj = 0; bj < 2; ++bj)
#pragma unroll
                    for (int n = 0; n < 2; ++n) { const f32x4 r = *(const f32x4*)(rp + bj * HALF + n * 16); *(f32x4*)(op + bj * HALF + n * 16) = r * alpha + acc[ai][bj][m][n] * scale; }
                asm volatile("" ::: "memory");
            }
    }
};

struct EpiZ {
    static constexpr bool PERM = true, AFTER_DRAIN = false;
    bf16_t *QG, *KG, *VG, *GG, *QS, *KS, *VS, *SGG, *SGS; float* RG; const float* bias; float* out;
    __device__ __forceinline__ void operator()(const f32x4 (&acc)[2][2][4][2], const Unit& u, int wr, int wc, int fr, int fq) const {
        const int pn = u.pn; const int row0 = u.pm * BM + wr * 64 + fr; const int cl = wc * 32 + 8 * fq;
        if (pn == 52) {
            if (wc == 0 && fq < 2) {
                const f32x4 b0 = *(const f32x4*)(bias + 52 * 256 + cl), b1 = *(const f32x4*)(bias + 52 * 256 + cl + 4);
#pragma unroll
                for (int ai = 0; ai < 2; ++ai)
#pragma unroll
                    for (int m = 0; m < 4; ++m) { float* rp = RG + (size_t)(row0 + ai * HALF + m * 16) * 16 + cl;
                        *(f32x4*)rp = acc[ai][0][m][0] + b0; *(f32x4*)(rp + 4) = acc[ai][0][m][1] + b1; }
            }
            return;
        }
        bf16_t* dst; int ld, colt, mode = 0, cache = 0; float sc = 1.f;
        if (pn < 4) { dst = QG; ld = 1024; colt = pn * 256; sc = 0.0625f; }
        else if (pn < 8) { dst = KG; ld = 1024; colt = (pn - 4) * 256; }
        else if (pn < 16) { dst = VG; ld = 2048; colt = (pn - 8) * 256; }
        else if (pn < 24) { dst = GG; ld = 2048; colt = (pn - 16) * 256; mode = 1; }
        else if (pn < 32) { dst = QS; ld = 2048; colt = (pn - 24) * 256; sc = 0.125f; }
        else if (pn < 34) { dst = KS; ld = 512; colt = (pn - 32) * 256; cache = 1; }
        else if (pn < 36) { dst = VS; ld = 512; colt = (pn - 34) * 256; cache = 2; }
        else if (pn < 44) { dst = SGG; ld = 2048; colt = (pn - 36) * 256; mode = 2; }
        else { dst = SGS; ld = 2048; colt = (pn - 44) * 256; mode = 2; }
        f32x4 bv[2][2];
#pragma unroll
        for (int bj = 0; bj < 2; ++bj)
#pragma unroll
            for (int n = 0; n < 2; ++n) bv[bj][n] = *(const f32x4*)(bias + pn * 256 + bj * HALF + cl + 4 * n);
#pragma unroll
        for (int ai = 0; ai < 2; ++ai)
#pragma unroll
            for (int m = 0; m < 4; ++m) {
                const int row = row0 + ai * HALF + m * 16;
                float* cp = nullptr;
                if (cache) {
                    if (row >= 8192) { const int rr = row - 8192; cp = out + (cache == 1 ? 86638592ull : 95027200ull) + ((size_t)((rr >> 3) * 128 + 120 + (rr & 7))) * 512; }
                    else if (row >= 8064) cp = out + (cache == 1 ? 19398656ull : 19464192ull) + (size_t)(row - 8064) * 512;
                }
#pragma unroll
                for (int bj = 0; bj < 2; ++bj) {
                    f32x4 v0 = acc[ai][bj][m][0] + bv[bj][0], v1 = acc[ai][bj][m][1] + bv[bj][1];
                    const int col = colt + bj * HALF + cl;
                    if (cp) { *(f32x4*)(cp + col) = v0; *(f32x4*)(cp + col + 4) = v1; }
                    if (mode == 1) {
#pragma unroll
                        for (int j = 0; j < 4; ++j) { v0[j] = fast_silu(v0[j]); v1[j] = fast_silu(v1[j]); }
                    } else if (mode == 2) {
#pragma unroll
                        for (int j = 0; j < 4; ++j) { v0[j] = fast_sigmoid(v0[j]); v1[j] = fast_sigmoid(v1[j]); }
                    } else { v0 = v0 * sc; v1 = v1 * sc; }
                    u32x4 w; w.x = cvt_pk_bf16(v0[0], v0[1]); w.y = cvt_pk_bf16(v0[2], v0[3]); w.z = cvt_pk_bf16(v1[0], v1[1]); w.w = cvt_pk_bf16(v1[2], v1[3]);
                    *(u32x4*)(dst + (size_t)row * ld + col) = w;
                }
            }
    }
};

struct EpiGateMul {
    static constexpr bool PERM = false, AFTER_DRAIN = false;
    const bf16_t* G; float* M1;
    __device__ __forceinline__ void operator()(const f32x4 (&acc)[2][2][4][2], const Unit& u, int wr, int wc, int fr, int fq) const {
        const int row0 = u.pm * BM + wr * 64 + fr, col0 = u.pn * BM + wc * 32 + 4 * fq;
#pragma unroll
        for (int ai = 0; ai < 2; ++ai)
#pragma unroll
            for (int m = 0; m < 4; ++m) {
                const size_t off = (size_t)(row0 + ai * HALF + m * 16) * 2048 + col0;
#pragma unroll
                for (int bj = 0; bj < 2; ++bj)
#pragma unroll
                    for (int n = 0; n < 2; ++n) { const u32x2 g = *(const u32x2*)(G + off + bj * HALF + n * 16);
                        f32x4 gv = {bf_lo(g.x), bf_hi(g.x), bf_lo(g.y), bf_hi(g.y)};
                        *(f32x4*)(M1 + off + bj * HALF + n * 16) = gv * acc[ai][bj][m][n]; }
            }
    }
};

struct EpiMerge {
    static constexpr bool PERM = true, AFTER_DRAIN = false;
    const bf16_t* G; const float* M1; bf16_t* MG;
    __device__ __forceinline__ void operator()(const f32x4 (&acc)[2][2][4][2], const Unit& u, int wr, int wc, int fr, int fq) const {
        const int row0 = u.pm * BM + wr * 64 + fr, col0 = u.pn * BM + wc * 32 + 8 * fq;
#pragma unroll
        for (int ai = 0; ai < 2; ++ai)
#pragma unroll
            for (int m = 0; m < 4; ++m) {
                const size_t off = (size_t)(row0 + ai * HALF + m * 16) * 2048 + col0;
#pragma unroll
                for (int bj = 0; bj < 2; ++bj) {
                    const u32x4 g = *(const u32x4*)(G + off + bj * HALF);
                    const f32x4 ma = *(const f32x4*)(M1 + off + bj * HALF), mb = *(const f32x4*)(M1 + off + bj * HALF + 4);
                    const f32x4 g0 = {bf_lo(g.x), bf_hi(g.x), bf_lo(g.y), bf_hi(g.y)}, g1 = {bf_lo(g.z), bf_hi(g.z), bf_lo(g.w), bf_hi(g.w)};
                    const f32x4 v0 = ma + g0 * acc[ai][bj][m][0], v1 = mb + g1 * acc[ai][bj][m][1];
                    u32x4 w; w.x = cvt_pk_bf16(v0[0], v0[1]); w.y = cvt_pk_bf16(v0[2], v0[3]); w.z = cvt_pk_bf16(v1[0], v1[1]); w.w = cvt_pk_bf16(v1[2], v1[3]);
                    *(u32x4*)(MG + off + bj * HALF) = w;
                }
            }
    }
};

template <class Epi, class Sched, bool ALIGN_EPI = false, bool SP2 = false>
__device__ __forceinline__ void gemm_phase(PG8_LAS unsigned char* lds, const Gemm g, const Sched& S, const Epi& E) {
    const int tid = threadIdx.x, wid = __builtin_amdgcn_readfirstlane(tid >> 6), lane = tid & 63, wr = wid >> 2, wc = wid & 3, fr = lane & 15, fq = lane >> 4;
    const int K = g.K, nt = K / BK;
    unsigned voffA[2], voffB[2];
#pragma unroll
    for (int i = 0; i < 2; ++i) { int R, C; stage_rc(tid * 16 + i * 8192, R, C); const int Rb = Epi::PERM ? ((R & ~31) + perm32(R & 31)) : R;
        voffA[i] = (unsigned)(R * K + C) * 2u; voffB[i] = (unsigned)(Rb * K + C) * 2u; }
    const size_t kstep = (size_t)(BK * 2);
    const size_t hstep = (size_t)HALF * K * 2;
    const size_t tstep = 2 * hstep;
    const unsigned ldsw = (unsigned)wid * 1024u;
    const int aoff = lds_byte(wr * 64 + fr, fq * 8), boff = lds_byte(wc * 32 + fr, fq * 8);
#define PG8_SA(b, h) (((b) * 2 + (h)) * HTB)
#define PG8_SB(b, h) ((4 + (b) * 2 + (h)) * HTB)
#define PG8_STAGE(bufoff, gbase, voff) do { _Pragma("unroll") for (int _i = 0; _i < 2; ++_i) \
        __builtin_amdgcn_global_load_lds((const unsigned*)((const char*)(gbase) + (voff)[_i]), (PG8_LAS unsigned*)(lds + (bufoff) + ldsw + _i * 8192), 16, 0, 0); } while (0)
#define PG8_LDA(dst, b, h) do { _Pragma("unroll") for (int m = 0; m < 4; ++m) _Pragma("unroll") for (int k = 0; k < 2; ++k) dst[m][k] = *(const PG8_LAS bf16x8*)(lds + PG8_SA(b, h) + aoff + m * 2048 + k * 1024); } while (0)
#define PG8_LDB(dst, b, h) do { _Pragma("unroll") for (int n = 0; n < 2; ++n) _Pragma("unroll") for (int k = 0; k < 2; ++k) dst[n][k] = *(const PG8_LAS bf16x8*)(lds + PG8_SB(b, h) + boff + n * 2048 + k * 1024); } while (0)
#define PG8_MMA(ai, bj, At, Bt) do { __builtin_amdgcn_s_setprio(1); _Pragma("unroll") for (int m = 0; m < 4; ++m) _Pragma("unroll") for (int n = 0; n < 2; ++n) _Pragma("unroll") for (int k = 0; k < 2; ++k) \
        acc[ai][bj][m][n] = __builtin_amdgcn_mfma_f32_16x16x32_bf16(Bt[n][k], At[m][k], acc[ai][bj][m][n], 0, 0, 0); __builtin_amdgcn_s_setprio(0); } while (0)
#define PG8_WAIT_V(n) asm volatile("s_waitcnt vmcnt(" #n ")" ::: "memory")
#define PG8_WAIT_L(n) asm volatile("s_waitcnt lgkmcnt(" #n ")" ::: "memory")
#define PG8_BAR __builtin_amdgcn_s_barrier()
#define PG8_SCHED __builtin_amdgcn_sched_barrier(0)
    Unit cur, nxt; int ui = 0;
    if (!S.next(0, cur)) return;
    f32x4 acc[2][2][4][2];
#pragma unroll
    for (int a = 0; a < 2; ++a)
#pragma unroll
        for (int b = 0; b < 2; ++b)
#pragma unroll
            for (int m = 0; m < 4; ++m)
#pragma unroll
                for (int n = 0; n < 2; ++n) acc[a][b][m][n] = (f32x4){0.f, 0.f, 0.f, 0.f};
    bf16x8 At[4][2], B0[2][2], B1[2][2];
    const char* cA = (const char*)g.A + (size_t)cur.pm * tstep; const char* cB = (const char*)g.Bt + (size_t)cur.pn * tstep;
    S.a_ready(cur);
    if constexpr (SP2) {
        PG8_STAGE(PG8_SB(0, 0), cB, voffB); PG8_STAGE(PG8_SB(0, 1), cB + hstep, voffB); PG8_STAGE(PG8_SA(0, 0), cA, voffA); PG8_STAGE(PG8_SA(0, 1), cA + hstep, voffA);
        if (wr == 1) PG8_BAR;
        PG8_WAIT_V(2); PG8_BAR;
        PG8_STAGE(PG8_SB(1, 0), cB + kstep, voffB); PG8_STAGE(PG8_SA(1, 0), cA + kstep, voffA); PG8_STAGE(PG8_SB(1, 1), cB + hstep + kstep, voffB);
        PG8_WAIT_V(6); PG8_BAR;
    } else {
        PG8_STAGE(PG8_SB(0, 0), cB, voffB); PG8_STAGE(PG8_SA(0, 0), cA, voffA); PG8_STAGE(PG8_SB(0, 1), cB + hstep, voffB); PG8_STAGE(PG8_SA(0, 1), cA + hstep, voffA);
        if (wr == 1) PG8_BAR;
        PG8_WAIT_V(4); PG8_BAR;
        PG8_STAGE(PG8_SB(1, 0), cB + kstep, voffB); PG8_STAGE(PG8_SA(1, 0), cA + kstep, voffA); PG8_STAGE(PG8_SB(1, 1), cB + hstep + kstep, voffB);
        PG8_WAIT_V(6); PG8_BAR;
    }
    for (;;) {
        const bool has_next = S.next(ui + 1, nxt);
        const char* nA = has_next ? (const char*)g.A + (size_t)nxt.pm * tstep : cA; const char* nB = has_next ? (const char*)g.Bt + (size_t)nxt.pn * tstep : cB;
        for (int t = 0; t < nt; t += 2) {
            const bool last = (t == nt - 2);
            const char* a1 = cA + (size_t)(t + 1) * kstep;
            const char* a2 = last ? nA : cA + (size_t)(t + 2) * kstep; const char* b2 = last ? nB : cB + (size_t)(t + 2) * kstep;
            const char* a3 = a2 + kstep; const char* b3 = b2 + kstep;
            if (last && has_next) S.a_ready(nxt);
            if constexpr (SP2) {
            PG8_LDB(B0, 0, 0); PG8_LDB(B1, 0, 1); PG8_SCHED; PG8_LDA(At, 0, 0); PG8_STAGE(PG8_SA(1, 1), a1 + hstep, voffA);
            PG8_WAIT_V(8); PG8_WAIT_L(0); PG8_BAR; PG8_MMA(0, 0, At, B0); PG8_MMA(0, 1, At, B1); PG8_BAR; PG8_SCHED;
            PG8_LDA(At, 0, 1); PG8_STAGE(PG8_SB(0, 0), b2, voffB); PG8_STAGE(PG8_SB(0, 1), b2 + hstep, voffB); PG8_STAGE(PG8_SA(0, 0), a2, voffA);
            PG8_WAIT_V(8); PG8_WAIT_L(0); PG8_BAR; PG8_MMA(1, 0, At, B0); PG8_MMA(1, 1, At, B1); PG8_BAR; PG8_SCHED;
            PG8_LDB(B0, 1, 0); PG8_LDB(B1, 1, 1); PG8_SCHED; PG8_LDA(At, 1, 0); PG8_STAGE(PG8_SA(0, 1), a2 + hstep, voffA);
            PG8_WAIT_V(8); PG8_WAIT_L(0); PG8_BAR; PG8_MMA(0, 0, At, B0); PG8_MMA(0, 1, At, B1); PG8_BAR; PG8_SCHED;
            PG8_LDA(At, 1, 1); PG8_STAGE(PG8_SB(1, 0), b3, voffB); PG8_STAGE(PG8_SB(1, 1), b3 + hstep, voffB); PG8_STAGE(PG8_SA(1, 0), a3, voffA);
            PG8_WAIT_V(8); PG8_WAIT_L(0); PG8_BAR; PG8_MMA(1, 0, At, B0); PG8_MMA(1, 1, At, B1); PG8_BAR; PG8_SCHED;
            } else {
            PG8_LDB(B0, 0, 0); PG8_SCHED; PG8_LDA(At, 0, 0); PG8_STAGE(PG8_SA(1, 1), a1 + hstep, voffA);
            PG8_WAIT_L(8); PG8_BAR; PG8_WAIT_L(0); PG8_MMA(0, 0, At, B0); PG8_BAR; PG8_SCHED;
            PG8_LDB(B1, 0, 1); PG8_STAGE(PG8_SB(0, 0), b2, voffB);
            PG8_BAR; PG8_WAIT_L(0); PG8_MMA(0, 1, At, B1); PG8_BAR;
            PG8_LDA(At, 0, 1); PG8_STAGE(PG8_SA(0, 0), a2, voffA);
            PG8_BAR; PG8_WAIT_L(0); PG8_MMA(1, 0, At, B0); PG8_BAR; PG8_SCHED;
            PG8_STAGE(PG8_SB(0, 1), b2 + hstep, voffB);
            PG8_WAIT_V(6); PG8_BAR; PG8_MMA(1, 1, At, B1); PG8_BAR;
            PG8_LDB(B0, 1, 0); PG8_SCHED; PG8_LDA(At, 1, 0); PG8_STAGE(PG8_SA(0, 1), a2 + hstep, voffA);
            PG8_WAIT_L(8); PG8_BAR; PG8_WAIT_L(0); PG8_MMA(0, 0, At, B0); PG8_BAR; PG8_SCHED;
            PG8_LDB(B1, 1, 1); PG8_STAGE(PG8_SB(1, 0), b3, voffB);
            PG8_BAR; PG8_WAIT_L(0); PG8_MMA(0, 1, At, B1); PG8_BAR;
            PG8_LDA(At, 1, 1); PG8_STAGE(PG8_SA(1, 0), a3, voffA);
            PG8_BAR; PG8_WAIT_L(0); PG8_MMA(1, 0, At, B0); PG8_BAR; PG8_SCHED;
            PG8_STAGE(PG8_SB(1, 1), b3 + hstep, voffB);
            PG8_WAIT_V(6); PG8_BAR; PG8_MMA(1, 1, At, B1); PG8_BAR;
            }
        }
        if constexpr (ALIGN_EPI) { if (wr == 0) PG8_BAR; }
        if constexpr (!Epi::AFTER_DRAIN) { E(acc, cur, wr, wc, fr, fq); S.done(cur); }
        if (!has_next) break;
#pragma unroll
        for (int a = 0; a < 2; ++a)
#pragma unroll
            for (int b = 0; b < 2; ++b)
#pragma unroll
                for (int m = 0; m < 4; ++m)
#pragma unroll
                    for (int n = 0; n < 2; ++n) acc[a][b][m][n] = (f32x4){0.f, 0.f, 0.f, 0.f};
        cur = nxt; cA = nA; cB = nB; ++ui;
        if constexpr (ALIGN_EPI) { if (wr == 1) PG8_BAR; }
    }
    PG8_WAIT_V(0);
    if constexpr (!ALIGN_EPI) { if (wr == 0) PG8_BAR; }
    PG8_BAR;
    if constexpr (Epi::AFTER_DRAIN) { E.fused(acc, cur, wr, wc, fr, fq, lds, wid, lane); S.done(cur); }
#undef PG8_SA
#undef PG8_SB
#undef PG8_STAGE
#undef PG8_LDA
#undef PG8_LDB
#undef PG8_MMA
#undef PG8_WAIT_V
#undef PG8_WAIT_L
#undef PG8_BAR
#undef PG8_SCHED
}
}

#define DI __device__ __forceinline__
#define LAS __attribute__((address_space(3)))
typedef unsigned short bf16;
typedef short bf16x8 __attribute__((ext_vector_type(8)));
typedef float f32x4 __attribute__((ext_vector_type(4)));
typedef float f32x16 __attribute__((ext_vector_type(16)));
typedef unsigned u32x4 __attribute__((ext_vector_type(4)));
typedef unsigned u32x2 __attribute__((ext_vector_type(2)));
typedef __bf16 bf16x2_t __attribute__((ext_vector_type(2)));
typedef float f32x2_t __attribute__((ext_vector_type(2)));

constexpr int NWAVES = 8, NTHR = 512;
constexpr int DM = 2048, MP = 8192, MS = 1024, MT = 9216, DFF = 5632, DIN = 13328, DINP = 13568;
constexpr int NCH = 128;
constexpr float ALPHA = 1.189207115002721f;
constexpr float LN_EPS = 1e-5f, RMS_EPS = 1e-6f;
constexpr size_t O_YP = 0, O_SP = 18874368ull, O_KP = 19398656ull, O_VP = 19464192ull, O_SS = 19529728ull, O_KS = 86638592ull, O_VS = 95027200ull, O_END = 103415808ull;
constexpr size_t MiB = 1ull << 20;
constexpr size_t WS_CTL = 0, CTL_ZERO_BYTES = 1 * MiB;
constexpr size_t WS_WF1 = 1 * MiB, WS_WF2 = 45 * MiB, WS_WIN = 67 * MiB, WS_WBG = 120 * MiB, WS_WBS = 128 * MiB, WS_WO = 136 * MiB, WS_BP = 144 * MiB;
constexpr size_t WS_XB = 145 * MiB, WS_HB = 181 * MiB, WS_ST = 181 * MiB, WS_Y = 309 * MiB, WS_X = 381 * MiB;
constexpr size_t WS_QG = 453 * MiB, WS_KG = 471 * MiB, WS_VG = 489 * MiB, WS_GG = 525 * MiB, WS_QS = 561 * MiB, WS_KS = 597 * MiB, WS_VS = 606 * MiB;
constexpr size_t WS_SGG = 615 * MiB, WS_SGS = 651 * MiB, WS_RG = 687 * MiB, WS_AQ = 688 * MiB, WS_KDT = 704 * MiB, WS_PP = 720 * MiB, WS_DEC = 724 * MiB;
constexpr size_t WS_VT = 725 * MiB, WS_VST = 757 * MiB, WS_OG = 765 * MiB, WS_OS = 801 * MiB, WS_MG = 837 * MiB, WS_END = 873 * MiB;
constexpr int CW_QUEUE = 64;
constexpr int LDS_BYTES = 147456;
constexpr int LDS_MISC = 143360;

DI float bf2f(unsigned short b) { return __uint_as_float((unsigned)b << 16); }
DI float bflo(unsigned w) { return __uint_as_float(w << 16); }
DI float bfhi(unsigned w) { return __uint_as_float(w & 0xffff0000u); }
DI unsigned pk2(float lo, float hi) { f32x2_t v = {lo, hi}; bf16x2_t b = __builtin_convertvector(v, bf16x2_t); return __builtin_bit_cast(unsigned, b); }
DI unsigned short f2bf(float f) { return (unsigned short)(pk2(f, 0.f) & 0xffffu); }
DI float wave_sum(float v) {
#pragma unroll
    for (int o = 1; o < 64; o <<= 1) v += __shfl_xor(v, o);
    return v;
}
DI float logsig16(float x) { return (fminf(x, 0.f) - log1pf(__expf(-fabsf(x)))) * 0.0625f; }
#define MFMA32(a, b, c) __builtin_amdgcn_mfma_f32_32x32x16_bf16((a), (b), (c), 0, 0, 0)
#define MFMA16(a, b, c) __builtin_amdgcn_mfma_f32_16x16x32_bf16((a), (b), (c), 0, 0, 0)
#define LDS_WAIT() asm volatile("s_waitcnt lgkmcnt(0)" ::: "memory")

struct Args { const float* in[24]; float* out; unsigned char* ws; int ph_lo, ph_hi; };

struct Ctx {
    LAS unsigned char* lds; int tid, lane, wave, G, bid;
    const float* const* in; float* out; unsigned char* ws;
};
#define WSP(T, off) ((T*)(C.ws + (off)))

DI void transpose_item(const float* W, int ldw, int k0, int n_src0, int nvalid, bf16* WT, int K, int dst_row0, LAS float* scr, int lane) {
    const int c = lane & 31;
#pragma unroll 8
    for (int i = 0; i < 32; ++i) { const int kk = 2 * i + (lane >> 5); float v = 0.f; if (c < nvalid) v = W[(size_t)(k0 + kk) * ldw + n_src0 + c]; scr[kk * 33 + c] = v; }
    LDS_WAIT(); asm volatile("" ::: "memory");
    const int c8 = lane & 7;
#pragma unroll
    for (int j = 0; j < 4; ++j) { const int n = (lane >> 3) + 8 * j; const LAS float* s = scr + (8 * c8) * 33 + n;
        u32x4 o; o.x = pk2(s[0 * 33], s[1 * 33]); o.y = pk2(s[2 * 33], s[3 * 33]); o.z = pk2(s[4 * 33], s[5 * 33]); o.w = pk2(s[6 * 33], s[7 * 33]);
        *(u32x4*)(WT + (size_t)(dst_row0 + n) * K + k0 + 8 * c8) = o; }
    LDS_WAIT(); asm volatile("" ::: "memory");
}
DI void conv_ffn(const Ctx& C, const float* w_in_, const float* w_out_) {
    LAS float* scr = (LAS float*)(C.lds + C.wave * 16384);
    const int gw = C.bid * NWAVES + C.wave, NGW = C.G * NWAVES;
    bf16* W1T = WSP(bf16, WS_WF1); bf16* W1OT = WSP(bf16, WS_WF2);
    constexpr int I1 = 32 * 352, I2 = 88 * 64;
    for (int it = gw; it < I1 + I2; it += NGW) {
        if (it < I1) { const int kb = it / 352, nb = it % 352, nd = 32 * nb, pn = nd >> 8, wi = nd & 255;
            const int src = (wi < 128) ? 128 * pn + wi : DFF + 128 * pn + (wi - 128);
            transpose_item(w_in_, 2 * DFF, 64 * kb, src, 32, W1T, DM, nd, scr, C.lane); }
        else { const int r = it - I1, kb = r / 64, nb = r % 64;
            transpose_item(w_out_, DM, 64 * kb, 32 * nb, 32, W1OT, DFF, 32 * nb, scr, C.lane); }
    }
}
DI void p0_prologue(const Ctx& C) {
    LAS float* scr = (LAS float*)(C.lds + C.wave * 16384);
    const int gw = C.bid * NWAVES + C.wave, NGW = C.G * NWAVES;
    conv_ffn(C, C.in[5], C.in[6]);
    bf16* WINT = WSP(bf16, WS_WIN);
    constexpr int I3 = 32 * 424, I4 = 32 * 64;
    for (int it = gw; it < I3 + 3 * I4; it += NGW) {
        if (it < I3) { const int kb = it / 424, nb = it % 424, nd = 32 * nb; int src = 0, nv = 32;
            if (nd < 6144) src = nd; else if (nd < 13312) src = nd + 16; else if (nd == 13312) { src = 6144; nv = 16; } else nv = 0;
            transpose_item(C.in[9], DIN, 64 * kb, src, nv, WINT, DM, nd, scr, C.lane); }
        else { int r = it - I3; const int which = r / I4; r -= which * I4; const int kb = r / 64, nb = r % 64;
            const float* W = C.in[15 + which]; bf16* WT = WSP(bf16, which == 0 ? WS_WBG : (which == 1 ? WS_WBS : WS_WO));
            transpose_item(W, DM, 64 * kb, 32 * nb, 32, WT, DM, 32 * nb, scr, C.lane); }
    }
    bf16* XB = WSP(bf16, WS_XB);
    for (int m = gw; m < MT; m += NGW) {
        const float* xr = (m < MP) ? C.in[0] + (size_t)m * DM : C.in[1] + (size_t)(m - MP) * DM;
        const f32x4* x4 = (const f32x4*)xr + C.lane; u32x2* o = (u32x2*)(XB + (size_t)m * DM) + C.lane;
#pragma unroll
        for (int j = 0; j < 8; ++j) { const f32x4 v = x4[64 * j]; u32x2 w; w.x = pk2(v.x, v.y); w.y = pk2(v.z, v.w); o[64 * j] = w; }
    }
    float* BP = WSP(float, WS_BP); const float* b_in = C.in[10];
    for (int i = C.bid * NTHR + C.tid; i < DINP; i += C.G * NTHR) {
        float v = 0.f; if (i < 6144) v = b_in[i]; else if (i < 13312) v = b_in[i + 16]; else if (i < 13328) v = b_in[i - 13312 + 6144];
        BP[i] = v; }
}
DI void ln_phase(const Ctx& C, const float* Y, const float* w, const float* b, float* Xf, bf16* XB) {
    const int gw = C.bid * NWAVES + C.wave, NGW = C.G * NWAVES;
    for (int m = gw; m < MT; m += NGW) {
        const f32x4* y4 = (const f32x4*)(Y + (size_t)m * DM) + C.lane;
        f32x4 v[8]; float s = 0.f;
#pragma unroll
        for (int j = 0; j < 8; ++j) { v[j] = y4[64 * j]; s += (v[j].x + v[j].y) + (v[j].z + v[j].w); }
        const float mean = wave_sum(s) * (1.f / DM); float s2 = 0.f;
#pragma unroll
        for (int j = 0; j < 8; ++j) { v[j] = v[j] - mean; s2 += (v[j].x * v[j].x + v[j].y * v[j].y) + (v[j].z * v[j].z + v[j].w * v[j].w); }
        const float rstd = 1.f / sqrtf(wave_sum(s2) * (1.f / DM) + LN_EPS);
        const f32x4* w4 = (const f32x4*)w + C.lane; const f32x4* b4 = (const f32x4*)b + C.lane;
#pragma unroll
        for (int j = 0; j < 8; ++j) { const f32x4 o = v[j] * rstd * w4[64 * j] + b4[64 * j];
            if (Xf) ((f32x4*)(Xf + (size_t)m * DM) + C.lane)[64 * j] = o;
            if (XB) { u32x2 p; p.x = pk2(o.x, o.y); p.y = pk2(o.z, o.w); ((u32x2*)(XB + (size_t)m * DM) + C.lane)[64 * j] = p; } }
    }
}

DI void g1_item(const Ctx& C, int item) {
    const int c = item >> 2, h = item & 3, tid = C.tid, lane = C.lane, w = C.wave;
    LAS float* rgs = (LAS float*)(C.lds);
    LAS float* tot = (LAS float*)(C.lds + 4096);
    LAS unsigned short* sAq = (LAS unsigned short*)(C.lds + 8192);
    LAS unsigned short* sBk = (LAS unsigned short*)(C.lds + 8192 + 33792);
    const float* RG = WSP(float, WS_RG); const bf16* QG = WSP(bf16, WS_QG); const bf16* KG = WSP(bf16, WS_KG);
    bf16* AQ = WSP(bf16, WS_AQ); bf16* KDT = WSP(bf16, WS_KDT); bf16* PP = WSP(bf16, WS_PP); float* DEC = WSP(float, WS_DEC);
    const int t0 = c * 64;
    for (int i = tid; i < 64 * 16; i += NTHR) rgs[i] = RG[(size_t)t0 * 16 + i];
    const int k = tid & 255, half = tid >> 8;
    float wg[16];
#pragma unroll
    for (int r = 0; r < 16; ++r) wg[r] = C.in[11][r * 1024 + h * 256 + k];
    const float bias = C.in[12][h * 256 + k];
    __syncthreads();
    float run = 0.f;
    for (int tt = 0; tt < 32; ++tt) { const int t = half * 32 + tt; float x = bias;
#pragma unroll
        for (int r = 0; r < 16; ++r) x += rgs[t * 16 + r] * wg[r];
        run += logsig16(x); }
    tot[half * 256 + k] = run;
    __syncthreads();
    const float t0s = tot[k], t1s = tot[256 + k];
    const float bl = t0s + t1s; run = half ? t0s : 0.f;
    unsigned kdp[16];
#pragma unroll
    for (int tp = 0; tp < 16; ++tp) {
        float kd2[2];
#pragma unroll
        for (int e = 0; e < 2; ++e) { const int t = half * 32 + 2 * tp + e; float x = bias;
#pragma unroll
            for (int r = 0; r < 16; ++r) x += rgs[t * 16 + r] * wg[r];
            run += logsig16(x);
            const float q = bf2f(QG[(size_t)(t0 + t) * 1024 + h * 256 + k]), kk = bf2f(KG[(size_t)(t0 + t) * 1024 + h * 256 + k]);
            sAq[t * 264 + k] = f2bf(q * __expf(run)); sBk[t * 264 + k] = f2bf(kk * __expf(-run)); kd2[e] = kk * __expf(bl - run); }
        kdp[tp] = pk2(kd2[0], kd2[1]);
    }
    { u32x4* dst = (u32x4*)(KDT + ((size_t)(c * 4 + h) * 256 + k) * 64 + half * 32);
#pragma unroll
      for (int i = 0; i < 4; ++i) { u32x4 v; v.x = kdp[4 * i]; v.y = kdp[4 * i + 1]; v.z = kdp[4 * i + 2]; v.w = kdp[4 * i + 3]; dst[i] = v; } }
    if (half == 0) DEC[(c * 4 + h) * 256 + k] = __expf(bl);
    __syncthreads();
#pragma unroll
    for (int i = 0; i < 4; ++i) { const int idx = tid + NTHR * i, row = idx >> 5, ch = idx & 31;
        const u32x4 v = *(const LAS u32x4*)(sAq + row * 264 + ch * 8); *(u32x4*)(AQ + ((size_t)(c * 4 + h) * 64 + row) * 256 + ch * 8) = v; }
    { const int mt = w >> 1, fr = lane & 15, fq = lane >> 4;
#pragma unroll
      for (int nn = 0; nn < 2; ++nn) { const int nt = 2 * (w & 1) + nn; f32x4 acc = {0.f, 0.f, 0.f, 0.f};
          if (nt <= mt) {
#pragma unroll
              for (int ks = 0; ks < 8; ++ks) { const bf16x8 a = *(const LAS bf16x8*)(sBk + (16 * nt + fr) * 264 + 32 * ks + 8 * fq);
                  const bf16x8 b = *(const LAS bf16x8*)(sAq + (16 * mt + fr) * 264 + 32 * ks + 8 * fq); acc = MFMA16(a, b, acc); } }
          const int t = 16 * mt + fr, s0 = 16 * nt + 4 * fq;
          u32x2 o; o.x = pk2(s0 <= t ? acc[0] : 0.f, s0 + 1 <= t ? acc[1] : 0.f); o.y = pk2(s0 + 2 <= t ? acc[2] : 0.f, s0 + 3 <= t ? acc[3] : 0.f);
          *(u32x2*)(PP + ((size_t)(c * 4 + h) * 64 + t) * 64 + s0) = o; } }
    __syncthreads();
}
DI void tr_item(const bf16* src, int ldc, bf16* dst, int item, LAS unsigned short* scr, int lane) {
    const int ncb = ldc / 32, tb = item / ncb, cb = item % ncb, t0 = 64 * tb, c0 = 32 * cb;
#pragma unroll
    for (int i = 0; i < 8; ++i) { const int row = 8 * i + (lane >> 3), ch = lane & 7;
        const u32x2 v = *(const u32x2*)(src + (size_t)(t0 + row) * ldc + c0 + 4 * ch); *(LAS u32x2*)(scr + row * 36 + 4 * ch) = v; }
    LDS_WAIT(); asm volatile("" ::: "memory");
    const int cc = lane & 31, th = lane >> 5; unsigned pw[16];
#pragma unroll
    for (int j = 0; j < 16; ++j) { const unsigned lo = scr[(32 * th + 2 * j) * 36 + cc], hi = scr[(32 * th + 2 * j + 1) * 36 + cc]; pw[j] = lo | (hi << 16); }
    u32x4* d = (u32x4*)(dst + (size_t)(c0 + cc) * 8192 + t0 + 32 * th);
#pragma unroll
    for (int i = 0; i < 4; ++i) { u32x4 v; v.x = pw[4 * i]; v.y = pw[4 * i + 1]; v.z = pw[4 * i + 2]; v.w = pw[4 * i + 3]; d[i] = v; }
    LDS_WAIT(); asm volatile("" ::: "memory");
}
DI void g2_item(const Ctx& C, int item) {
    const int h = item >> 4, vs = item & 15, w = C.wave, r = C.lane & 31, hh = C.lane >> 5;
    const bf16* KDT = WSP(bf16, WS_KDT); const bf16* VT = WSP(bf16, WS_VT); const float* DEC = WSP(float, WS_DEC); bf16* ST = WSP(bf16, WS_ST);
    const bf16* Ap = KDT + ((size_t)h * 256 + 32 * w + r) * 64 + 8 * hh;
    const bf16* Bp = VT + (size_t)(h * 512 + 32 * vs + r) * 8192 + 8 * hh;
    const float* Dp = DEC + h * 256 + 32 * w + 4 * hh;
    f32x16 S;
#pragma unroll
    for (int i = 0; i < 16; ++i) S[i] = 0.f;
    bf16x8 a[4], b[4]; f32x4 d[4];
#pragma unroll
    for (int ks = 0; ks < 4; ++ks) { a[ks] = *(const bf16x8*)(Ap + 16 * ks); b[ks] = *(const bf16x8*)(Bp + 16 * ks); d[ks] = *(const f32x4*)(Dp + 8 * ks); }
    for (int c = 0; c < NCH; ++c) {
        if (c > 0) { bf16* sp = ST + ((size_t)(c * 4 + h) * 512 + 32 * vs + r) * 256 + 32 * w + 4 * hh;
#pragma unroll
            for (int q = 0; q < 4; ++q) { u32x2 o; o.x = pk2(S[4 * q], S[4 * q + 1]); o.y = pk2(S[4 * q + 2], S[4 * q + 3]); *(u32x2*)(sp + 8 * q) = o; } }
        bf16x8 an[4], bn[4]; f32x4 dn[4];
        const int cn = (c + 1 < NCH) ? c + 1 : c;
#pragma unroll
        for (int ks = 0; ks < 4; ++ks) { an[ks] = *(const bf16x8*)(Ap + (size_t)cn * (4 * 256 * 64) + 16 * ks); bn[ks] = *(const bf16x8*)(Bp + 64 * cn + 16 * ks); dn[ks] = *(const f32x4*)(Dp + cn * 1024 + 8 * ks); }
#pragma unroll
        for (int q = 0; q < 4; ++q)
#pragma unroll
            for (int j = 0; j < 4; ++j) S[4 * q + j] *= d[q][j];
#pragma unroll
        for (int ks = 0; ks < 4; ++ks) S = MFMA32(a[ks], b[ks], S);
#pragma unroll
        for (int ks = 0; ks < 4; ++ks) { a[ks] = an[ks]; b[ks] = bn[ks]; d[ks] = dn[ks]; }
    }
    float* so = C.out + O_SP + ((size_t)h * 256 + 32 * w + 4 * hh) * 512 + 32 * vs + r;
#pragma unroll
    for (int q = 0; q < 4; ++q)
#pragma unroll
        for (int j = 0; j < 4; ++j) so[(size_t)(8 * q + j) * 512] = S[4 * q + j];
}
DI void g3_item(const Ctx& C, int item) {
    const int c = item >> 2, h = item & 3, w = C.wave, r = C.lane & 31, hh = C.lane >> 5, v0 = 64 * w;
    const bf16* ST = WSP(bf16, WS_ST); const bf16* AQ = WSP(bf16, WS_AQ); const bf16* PP = WSP(bf16, WS_PP); const bf16* VT = WSP(bf16, WS_VT);
    const bf16* GG = WSP(bf16, WS_GG); bf16* OG = WSP(bf16, WS_OG);
    LAS float* red = (LAS float*)(C.lds);
    f32x16 acc[2][2];
#pragma unroll
    for (int i = 0; i < 2; ++i)
#pragma unroll
        for (int j = 0; j < 2; ++j)
#pragma unroll
            for (int e = 0; e < 16; ++e) acc[i][j][e] = 0.f;
    if (c > 0) {
        const bf16* ap = ST + ((size_t)(c * 4 + h) * 512 + v0 + r) * 256 + 8 * hh;
        const bf16* bp = AQ + ((size_t)(c * 4 + h) * 64 + r) * 256 + 8 * hh;
#pragma unroll 4
        for (int ks = 0; ks < 16; ++ks) {
            const bf16x8 a0 = *(const bf16x8*)(ap + 16 * ks), a1 = *(const bf16x8*)(ap + 32 * 256 + 16 * ks);
            const bf16x8 b0 = *(const bf16x8*)(bp + 16 * ks), b1 = *(const bf16x8*)(bp + 32 * 256 + 16 * ks);
            acc[0][0] = MFMA32(a0, b0, acc[0][0]); acc[0][1] = MFMA32(a0, b1, acc[0][1]); acc[1][0] = MFMA32(a1, b0, acc[1][0]); acc[1][1] = MFMA32(a1, b1, acc[1][1]); }
    }
    { const bf16* ap = VT + (size_t)(h * 512 + v0 + r) * 8192 + 64 * c + 8 * hh;
      const bf16* bp = PP + ((size_t)(c * 4 + h) * 64 + r) * 64 + 8 * hh;
#pragma unroll
      for (int ks = 0; ks < 4; ++ks) {
          const bf16x8 a0 = *(const bf16x8*)(ap + 16 * ks), a1 = *(const bf16x8*)(ap + (size_t)32 * 8192 + 16 * ks);
          const bf16x8 b0 = *(const bf16x8*)(bp + 16 * ks), b1 = *(const bf16x8*)(bp + 32 * 64 + 16 * ks);
          acc[0][0] = MFMA32(a0, b0, acc[0][0]); acc[0][1] = MFMA32(a0, b1, acc[0][1]); acc[1][0] = MFMA32(a1, b0, acc[1][0]); acc[1][1] = MFMA32(a1, b1, acc[1][1]); } }
#pragma unroll
    for (int nt = 0; nt < 2; ++nt) { float s = 0.f;
#pragma unroll
        for (int mv = 0; mv < 2; ++mv)
#pragma unroll
            for (int e = 0; e < 16; ++e) s += acc[mv][nt][e] * acc[mv][nt][e];
        s += __shfl_xor(s, 32);
        if (hh == 0) red[w * 64 + 32 * nt + r] = s; }
    __syncthreads();
    const float* nw = C.in[13];
#pragma unroll
    for (int nt = 0; nt < 2; ++nt) { float tot = 0.f;
#pragma unroll
        for (int ww = 0; ww < 8; ++ww) tot += red[ww * 64 + 32 * nt + r];
        const float rs = 1.f / sqrtf(tot * (1.f / 512.f) + RMS_EPS);
        const size_t rowoff = (size_t)(64 * c + 32 * nt + r) * 2048 + h * 512;
#pragma unroll
        for (int mv = 0; mv < 2; ++mv)
#pragma unroll
            for (int q = 0; q < 4; ++q) { const int v = v0 + 32 * mv + 8 * q + 4 * hh;
                const f32x4 n4 = *(const f32x4*)(nw + v); const u32x2 g = *(const u32x2*)(GG + rowoff + v);
                u32x2 o; o.x = pk2(acc[mv][nt][4 * q] * rs * n4.x * bflo(g.x), acc[mv][nt][4 * q + 1] * rs * n4.y * bfhi(g.x));
                o.y = pk2(acc[mv][nt][4 * q + 2] * rs * n4.z * bflo(g.y), acc[mv][nt][4 * q + 3] * rs * n4.w * bfhi(g.y));
                *(u32x2*)(OG + rowoff + v) = o; } }
    __syncthreads();
}
DI void dgla_item(const Ctx& C, int item) {
    const int b = item >> 2, h = item & 3, tid = C.tid, lane = C.lane, w = C.wave, m0 = MP + 8 * b;
    LAS float* sAq = (LAS float*)(C.lds);
    LAS float* sKd = (LAS float*)(C.lds + 8192);
    LAS float* sDec = (LAS float*)(C.lds + 16384);
    LAS float* sB = (LAS float*)(C.lds + 17408);
    LAS float* sQ = (LAS float*)(C.lds + 25600);
    LAS float* sK = (LAS float*)(C.lds + 33792);
    LAS float* sSc = (LAS float*)(C.lds + 41984);
    LAS float* sSs = (LAS float*)(C.lds + 42240);
    LAS float* red = (LAS float*)(C.lds + 43008);
    const float* RG = WSP(float, WS_RG); const bf16* QG = WSP(bf16, WS_QG); const bf16* KG = WSP(bf16, WS_KG); const bf16* VG = WSP(bf16, WS_VG);
    const bf16* GG = WSP(bf16, WS_GG); bf16* OG = WSP(bf16, WS_OG);
    if (tid < 256) { const int k = tid; float wg[16];
#pragma unroll
        for (int r = 0; r < 16; ++r) wg[r] = C.in[11][r * 1024 + h * 256 + k];
        const float bias = C.in[12][h * 256 + k]; float bb[8], qq[8], kk[8]; float run = 0.f;
#pragma unroll
        for (int t = 0; t < 8; ++t) { float x = bias;
#pragma unroll
            for (int r = 0; r < 16; ++r) x += RG[(size_t)(m0 + t) * 16 + r] * wg[r];
            run += logsig16(x); bb[t] = run; qq[t] = bf2f(QG[(size_t)(m0 + t) * 1024 + h * 256 + k]); kk[t] = bf2f(KG[(size_t)(m0 + t) * 1024 + h * 256 + k]);
            sB[t * 256 + k] = run; sQ[t * 256 + k] = qq[t]; sK[t * 256 + k] = kk[t]; }
#pragma unroll
        for (int t = 0; t < 8; ++t) { sAq[k * 8 + t] = qq[t] * __expf(bb[t]); sKd[k * 8 + t] = kk[t] * __expf(bb[7] - bb[t]); }
        sDec[k] = __expf(bb[7]); }
    __syncthreads();
    { const int t = w;
      for (int s = 0; s < 8; ++s) { float p = 0.f;
          if (s <= t) {
#pragma unroll
              for (int i = 0; i < 4; ++i) { const int k = lane + 64 * i; p += sQ[t * 256 + k] * sK[s * 256 + k] * __expf(sB[t * 256 + k] - sB[s * 256 + k]); }
              p = wave_sum(p); }
          if (lane == 0) sSc[t * 8 + s] = p; } }
    const int v4 = tid & 127, kq = tid >> 7;
    f32x4 vv[8];
#pragma unroll
    for (int s = 0; s < 8; ++s) { const u32x2 g = *(const u32x2*)(VG + (size_t)(m0 + s) * 2048 + h * 512 + 4 * v4); vv[s] = (f32x4){bflo(g.x), bfhi(g.x), bflo(g.y), bfhi(g.y)}; }
    f32x4 acc[8];
#pragma unroll
    for (int t = 0; t < 8; ++t) acc[t] = (f32x4){0.f, 0.f, 0.f, 0.f};
    { const f32x4* S0 = (const f32x4*)(C.in[2] + ((size_t)(b * 4 + h) * 256 + kq * 64) * 512) + v4;
      f32x4* SN = (f32x4*)(C.out + O_SS + ((size_t)(b * 4 + h) * 256 + kq * 64) * 512) + v4;
#pragma unroll 4
      for (int kk = 0; kk < 64; ++kk) { const int k = kq * 64 + kk; const f32x4 s4 = S0[(size_t)kk * 128];
          const f32x4 a0 = *(const LAS f32x4*)(sAq + k * 8), a1 = *(const LAS f32x4*)(sAq + k * 8 + 4);
          const f32x4 k0 = *(const LAS f32x4*)(sKd + k * 8), k1 = *(const LAS f32x4*)(sKd + k * 8 + 4); const float dc = sDec[k];
          acc[0] += s4 * a0.x; acc[1] += s4 * a0.y; acc[2] += s4 * a0.z; acc[3] += s4 * a0.w; acc[4] += s4 * a1.x; acc[5] += s4 * a1.y; acc[6] += s4 * a1.z; acc[7] += s4 * a1.w;
          f32x4 sn = s4 * dc; sn += vv[0] * k0.x; sn += vv[1] * k0.y; sn += vv[2] * k0.z; sn += vv[3] * k0.w; sn += vv[4] * k1.x; sn += vv[5] * k1.y; sn += vv[6] * k1.z; sn += vv[7] * k1.w;
          SN[(size_t)kk * 128] = sn; } }
#pragma unroll
    for (int t = 0; t < 8; ++t) *(LAS f32x4*)(red + (size_t)((kq * 8 + t) * 512) + 4 * v4) = acc[t];
    __syncthreads();
    f32x4 o2[2];
#pragma unroll
    for (int e = 0; e < 2; ++e) { const int t = 2 * kq + e; f32x4 o = {0.f, 0.f, 0.f, 0.f};
#pragma unroll
        for (int q = 0; q < 4; ++q) o += *(const LAS f32x4*)(red + (size_t)((q * 8 + t) * 512) + 4 * v4);
#pragma unroll
        for (int s = 0; s < 8; ++s) o += vv[s] * sSc[t * 8 + s];
        o2[e] = o; float ss = (o.x * o.x + o.y * o.y) + (o.z * o.z + o.w * o.w); ss = wave_sum(ss);
        if (lane == 0) sSs[t * 2 + (w & 1)] = ss; }
    __syncthreads();
    const f32x4 n4 = *(const f32x4*)(C.in[13] + 4 * v4);
#pragma unroll
    for (int e = 0; e < 2; ++e) { const int t = 2 * kq + e; const float rs = 1.f / sqrtf((sSs[t * 2] + sSs[t * 2 + 1]) * (1.f / 512.f) + RMS_EPS);
        const size_t off = (size_t)(m0 + t) * 2048 + h * 512 + 4 * v4; const u32x2 g = *(const u32x2*)(GG + off);
        u32x2 o; o.x = pk2(o2[e].x * rs * n4.x * bflo(g.x), o2[e].y * rs * n4.y * bfhi(g.x)); o.y = pk2(o2[e].z * rs * n4.z * bflo(g.y), o2[e].w * rs * n4.w * bfhi(g.y));
        *(u32x2*)(OG + off) = o; }
    __syncthreads();
}
DI void dswa_item(const Ctx& C, int item) {
    const int b = item >> 3, kvh = item & 7, tid = C.tid, m0 = MP + 8 * b;
    LAS float* sK = (LAS float*)(C.lds);
    LAS float* sV = (LAS float*)(C.lds + 36992);
    LAS float* sQ = (LAS float*)(C.lds + 73984);
    LAS float* sP = (LAS float*)(C.lds + 82176);
    const bf16* QS = WSP(bf16, WS_QS); const bf16* KS = WSP(bf16, WS_KS); const bf16* VS = WSP(bf16, WS_VS); bf16* OS = WSP(bf16, WS_OS);
    for (int idx = tid; idx < 128 * 16; idx += NTHR) { const int row = idx >> 4, c4 = idx & 15;
        const size_t so = ((size_t)(b * 128 + row) * 8 + kvh) * 64 + 4 * c4;
        const f32x4 kv = *(const f32x4*)(C.in[3] + so), vv = *(const f32x4*)(C.in[4] + so);
        *(LAS f32x4*)(sK + row * 68 + 4 * c4) = kv; *(LAS f32x4*)(sV + row * 68 + 4 * c4) = vv;
        if (row >= 8) { const size_t oo = ((size_t)(b * 128 + row - 8) * 8 + kvh) * 64 + 4 * c4; *(f32x4*)(C.out + O_KS + oo) = kv; *(f32x4*)(C.out + O_VS + oo) = vv; } }
    if (tid < 128) { const int t = tid >> 4, c4 = tid & 15; const size_t so = (size_t)(m0 + t) * 512 + kvh * 64 + 4 * c4;
        const u32x2 kq = *(const u32x2*)(KS + so), vq = *(const u32x2*)(VS + so);
        *(LAS f32x4*)(sK + (128 + t) * 68 + 4 * c4) = (f32x4){bflo(kq.x), bfhi(kq.x), bflo(kq.y), bfhi(kq.y)};
        *(LAS f32x4*)(sV + (128 + t) * 68 + 4 * c4) = (f32x4){bflo(vq.x), bfhi(vq.x), bflo(vq.y), bfhi(vq.y)}; }
    { const int row = tid >> 4, c4 = tid & 15, g = row >> 3, t = row & 7;
      const u32x2 q = *(const u32x2*)(QS + (size_t)(m0 + t) * 2048 + (kvh * 4 + g) * 64 + 4 * c4);
      *(LAS f32x4*)(sQ + row * 64 + 4 * c4) = (f32x4){bflo(q.x), bfhi(q.x), bflo(q.y), bfhi(q.y)}; }
    __syncthreads();
    { const int row = tid >> 4, jl = tid & 15, g = row >> 3, t = row & 7, hq = kvh * 4 + g;
      const float slope = exp2f(-0.25f * (float)(hq + 1)), sink = C.in[14][hq];
      float sc[9]; float mx = -3.0e38f;
#pragma unroll
      for (int i = 0; i < 9; ++i) sc[i] = 0.f;
#pragma unroll 2
      for (int c4 = 0; c4 < 16; ++c4) { const f32x4 q = *(const LAS f32x4*)(sQ + row * 64 + 4 * c4);
#pragma unroll
          for (int i = 0; i < 9; ++i) { int j = jl + 16 * i; j = j < 136 ? j : 135; const f32x4 kx = *(const LAS f32x4*)(sK + j * 68 + 4 * c4); sc[i] += (q.x * kx.x + q.y * kx.y) + (q.z * kx.z + q.w * kx.w); } }
#pragma unroll
      for (int i = 0; i < 9; ++i) { const int j = jl + 16 * i; const int dist = 128 + t - j; float s = -3.0e38f;
          if (j < 136 && dist >= 0 && dist < 128) s = sc[i] - slope * (float)dist;
          sc[i] = s; mx = fmaxf(mx, s); }
#pragma unroll
      for (int o = 1; o < 16; o <<= 1) mx = fmaxf(mx, __shfl_xor(mx, o));
      mx = fmaxf(mx, sink); float sum = 0.f;
#pragma unroll
      for (int i = 0; i < 9; ++i) { const float e = (sc[i] > -1.0e38f) ? __expf(sc[i] - mx) : 0.f; sc[i] = e; sum += e; }
#pragma unroll
      for (int o = 1; o < 16; o <<= 1) sum += __shfl_xor(sum, o);
      const float inv = 1.f / (sum + __expf(sink - mx));
#pragma unroll
      for (int i = 0; i < 9; ++i) { const int j = jl + 16 * i; if (j < 136) sP[row * 136 + j] = sc[i] * inv; } }
    __syncthreads();
    { const int row = tid >> 4, dq = tid & 15, g = row >> 3, t = row & 7; f32x4 o = {0.f, 0.f, 0.f, 0.f};
      for (int j = 0; j < 136; ++j) { const float p = sP[row * 136 + j]; o += *(const LAS f32x4*)(sV + j * 68 + 4 * dq) * p; }
      u32x2 w; w.x = pk2(o.x, o.y); w.y = pk2(o.z, o.w);
      *(u32x2*)(OS + (size_t)(m0 + t) * 2048 + (kvh * 4 + g) * 64 + 4 * dq) = w; }
    __syncthreads();
}
DI void pswa_item(const Ctx& C, int item) {
    const int n = item >> 3, kvh = item & 7, w = C.wave, r = C.lane & 31, hh = C.lane >> 5, g = w >> 1, th = w & 1, hq = kvh * 4 + g;
    const bf16* QS = WSP(bf16, WS_QS); const bf16* KS = WSP(bf16, WS_KS); const bf16* VST = WSP(bf16, WS_VST); bf16* OS = WSP(bf16, WS_OS);
    const float slope = exp2f(-0.25f * (float)(hq + 1)), sink = C.in[14][hq];
#pragma unroll 1
    for (int pass = 0; pass < 2; ++pass) {
        const int i0 = 64 * th + 32 * pass, qtok = 128 * n + i0 + r;
        bf16x8 qf[4];
#pragma unroll
        for (int ks = 0; ks < 4; ++ks) qf[ks] = *(const bf16x8*)(QS + (size_t)qtok * 2048 + hq * 64 + 16 * ks + 8 * hh);
        f32x16 s[5];
#pragma unroll
        for (int jj = 0; jj < 5; ++jj) {
#pragma unroll
            for (int e = 0; e < 16; ++e) s[jj][e] = 0.f;
            int kt = (n - 1) * 128 + i0 + 32 * jj + r; kt = kt < 0 ? 0 : kt;
#pragma unroll
            for (int ks = 0; ks < 4; ++ks) { const bf16x8 kf = *(const bf16x8*)(KS + (size_t)kt * 512 + kvh * 64 + 16 * ks + 8 * hh); s[jj] = MFMA32(kf, qf[ks], s[jj]); }
            asm volatile("" ::: "memory"); }
        float mx = -3.0e38f;
        int rr = r - 4 * hh; asm volatile("" : "+v"(rr));
#pragma unroll
        for (int jj = 0; jj < 5; ++jj)
#pragma unroll
            for (int e = 0; e < 16; ++e) { const int cr0 = (e & 3) + 8 * (e >> 2); const int dist = 128 + rr - 32 * jj - cr0; const int j = i0 + 32 * jj + cr0 + 4 * hh;
                const bool valid = (dist >= 0) && (dist < 128) && (n > 0 || j >= 128);
                const float v = valid ? s[jj][e] - slope * (float)dist : -3.0e38f; s[jj][e] = v; mx = fmaxf(mx, v); }
        mx = fmaxf(mx, __shfl_xor(mx, 32)); mx = fmaxf(mx, sink);
        float sum = 0.f;
#pragma unroll
        for (int jj = 0; jj < 5; ++jj)
#pragma unroll
            for (int e = 0; e < 16; ++e) { const float p = (s[jj][e] > -1.0e38f) ? __expf(s[jj][e] - mx) : 0.f; s[jj][e] = p; sum += p; }
        sum += __shfl_xor(sum, 32);
        const float inv = 1.f / (sum + __expf(sink - mx));
        f32x16 o[2];
#pragma unroll
        for (int md = 0; md < 2; ++md)
#pragma unroll
            for (int e = 0; e < 16; ++e) o[md][e] = 0.f;
#pragma unroll
        for (int jj = 0; jj < 5; ++jj) {
            int kb = (n - 1) * 128 + i0 + 32 * jj; kb = kb < 0 ? 0 : kb;
#pragma unroll
            for (int st = 0; st < 2; ++st) {
                u32x4 pw; pw.x = pk2(s[jj][8 * st], s[jj][8 * st + 1]); pw.y = pk2(s[jj][8 * st + 2], s[jj][8 * st + 3]); pw.z = pk2(s[jj][8 * st + 4], s[jj][8 * st + 5]); pw.w = pk2(s[jj][8 * st + 6], s[jj][8 * st + 7]);
                const bf16x8 pb = __builtin_bit_cast(bf16x8, pw);
#pragma unroll
                for (int md = 0; md < 2; ++md) { const bf16* vp = VST + (size_t)(kvh * 64 + 32 * md + r) * 8192 + kb + 16 * st + 4 * hh;
                    const u32x2 lo = *(const u32x2*)vp, hi = *(const u32x2*)(vp + 8); u32x4 aw; aw.x = lo.x; aw.y = lo.y; aw.z = hi.x; aw.w = hi.y;
                    o[md] = MFMA32(__builtin_bit_cast(bf16x8, aw), pb, o[md]); } }
            asm volatile("" ::: "memory"); }
#pragma unroll
        for (int md = 0; md < 2; ++md)
#pragma unroll
            for (int q = 0; q < 4; ++q) { u32x2 ow; ow.x = pk2(o[md][4 * q] * inv, o[md][4 * q + 1] * inv); ow.y = pk2(o[md][4 * q + 2] * inv, o[md][4 * q + 3] * inv);
                *(u32x2*)(OS + (size_t)qtok * 2048 + hq * 64 + 32 * md + 8 * q + 4 * hh) = ow; }
    }
}

#ifndef MK_N_LAUNCHES
#define MK_N_LAUNCHES 1
#endif
constexpr int N_PHASES = 15;
__global__ void __launch_bounds__(NTHR, 2) hybrid_fwd(Args args) {
    extern __shared__ __attribute__((aligned(16))) unsigned char lds_raw[];
    Ctx C;
    C.lds = (LAS unsigned char*)lds_raw; C.tid = threadIdx.x; C.lane = C.tid & 63; C.wave = __builtin_amdgcn_readfirstlane(C.tid >> 6);
    C.G = gridDim.x; C.bid = blockIdx.x; C.in = args.in; C.out = args.out; C.ws = args.ws;
    const int lo = args.ph_lo, hi = args.ph_hi;
    unsigned* ctl = (unsigned*)(args.ws + WS_CTL);
    volatile LAS unsigned* misc = (volatile LAS unsigned*)(C.lds + LDS_MISC);
#ifndef PH_MASK
#define PH_MASK 0xFFFFFFFFu
#endif
#define IN(k) ((((PH_MASK) >> (k)) & 1u) && lo <= (k) && (k) < hi)
#define OPAQUE_CTX() Ctx C2 = C; asm volatile("" : "+v"(C2.tid), "+v"(C2.lane))
#define SEAM(k) do { if (IN(k) && IN((k) + 1)) { cg::this_grid().sync(); } } while (0)
    typedef pg8::bf16_t pb;
    if (IN(0)) { p0_prologue(C); }
    SEAM(0);
    if (IN(1)) { pg8::Gemm g{WSP(pb, WS_XB), WSP(pb, WS_WF1), MT, 2 * DFF, DM}; pg8::StaticOrder S; S.init(MT, 2 * DFF, C.G, C.bid);
        pg8::EpiSwiglu E{WSP(pb, WS_HB), DFF}; pg8::gemm_phase<pg8::EpiSwiglu, pg8::StaticOrder, true, true>(C.lds, g, S, E); }
    SEAM(1);
    if (IN(2)) { pg8::Gemm g{WSP(pb, WS_HB), WSP(pb, WS_WF2), MT, DM, DFF}; pg8::StaticOrder S; S.init(MT, DM, C.G, C.bid);
        pg8::EpiRes E{C.in[0], C.in[1], WSP(float, WS_Y), ALPHA, 0.5f}; pg8::gemm_phase<pg8::EpiRes, pg8::StaticOrder, true, true>(C.lds, g, S, E); }
    SEAM(2);
    if (IN(3)) { ln_phase(C, WSP(float, WS_Y), C.in[7], C.in[8], WSP(float, WS_X), WSP(bf16, WS_XB)); }
    SEAM(3);
    if (IN(4)) { pg8::Gemm g{WSP(pb, WS_XB), WSP(pb, WS_WIN), MT, DINP, DM}; pg8::StaticOrder S; S.init(MT, DINP, C.G, C.bid);
        pg8::EpiZ E{WSP(pb, WS_QG), WSP(pb, WS_KG), WSP(pb, WS_VG), WSP(pb, WS_GG), WSP(pb, WS_QS), WSP(pb, WS_KS), WSP(pb, WS_VS), WSP(pb, WS_SGG), WSP(pb, WS_SGS), WSP(float, WS_RG), WSP(float, WS_BP), C.out};
        pg8::gemm_phase<pg8::EpiZ, pg8::StaticOrder, true, true>(C.lds, g, S, E); }
    SEAM(4);
    if (IN(5)) {
        for (int it = C.bid; it < NCH * 4; it += C.G) { OPAQUE_CTX(); g1_item(C2, it); }
        for (int it = C.bid; it < 128 * 8; it += C.G) { OPAQUE_CTX(); dswa_item(C2, it); }
        { LAS unsigned short* scr = (LAS unsigned short*)(C.lds + C.wave * 8192); const int gw = C.bid * NWAVES + C.wave, NGW = C.G * NWAVES;
          for (int it = gw; it < 128 * 64 + 128 * 16; it += NGW) {
              if (it < 128 * 64) tr_item(WSP(bf16, WS_VG), 2048, WSP(bf16, WS_VT), it, scr, C.lane);
              else tr_item(WSP(bf16, WS_VS), 512, WSP(bf16, WS_VST), it - 128 * 64, scr, C.lane); } }
    }
    SEAM(5);
    if (IN(6)) {
        if (C.bid < 64) { OPAQUE_CTX(); g2_item(C2, C.bid); }
        for (;;) {
            if (C.tid == 0) misc[0] = __hip_atomic_fetch_add(ctl + CW_QUEUE, 1u, __ATOMIC_RELAXED, __HIP_MEMORY_SCOPE_AGENT);
            __syncthreads();
            const int it = (int)misc[0];
            __syncthreads();
            if (it >= 1024) break;
            OPAQUE_CTX();
            if (it < 512) dgla_item(C2, it); else pswa_item(C2, it - 512);
        }
    }
    SEAM(6);
    if (IN(7)) { for (int it = C.bid; it < NCH * 4; it += C.G) { OPAQUE_CTX(); g3_item(C2, it); } }
    SEAM(7);
    if (IN(8)) { pg8::Gemm g{WSP(pb, WS_OG), WSP(pb, WS_WBG), MT, DM, DM}; pg8::StaticOrder S; S.init(MT, DM, C.G, C.bid);
        pg8::EpiGateMul E{WSP(pb, WS_SGG), WSP(float, WS_Y)}; pg8::gemm_phase<pg8::EpiGateMul, pg8::StaticOrder, true, true>(C.lds, g, S, E); }
    SEAM(8);
    if (IN(9)) { pg8::Gemm g{WSP(pb, WS_OS), WSP(pb, WS_WBS), MT, DM, DM}; pg8::StaticOrder S; S.init(MT, DM, C.G, C.bid);
        pg8::EpiMerge E{WSP(pb, WS_SGS), WSP(float, WS_Y), WSP(pb, WS_MG)}; pg8::gemm_phase<pg8::EpiMerge, pg8::StaticOrder, true, true>(C.lds, g, S, E); }
    SEAM(9);
    if (IN(10)) { pg8::Gemm g{WSP(pb, WS_MG), WSP(pb, WS_WO), MT, DM, DM}; pg8::StaticOrder S; S.init(MT, DM, C.G, C.bid);
        pg8::EpiRes E{WSP(float, WS_X), WSP(float, WS_X) + (size_t)MP * DM, WSP(float, WS_Y), ALPHA, 1.0f}; pg8::gemm_phase<pg8::EpiRes, pg8::StaticOrder, true, true>(C.lds, g, S, E); }
    SEAM(10);
    if (IN(11)) { ln_phase(C, WSP(float, WS_Y), C.in[18], C.in[19], WSP(float, WS_X), WSP(bf16, WS_XB)); conv_ffn(C, C.in[20], C.in[21]); }
    SEAM(11);
    if (IN(12)) { pg8::Gemm g{WSP(pb, WS_XB), WSP(pb, WS_WF1), MT, 2 * DFF, DM}; pg8::StaticOrder S; S.init(MT, 2 * DFF, C.G, C.bid);
        pg8::EpiSwiglu E{WSP(pb, WS_HB), DFF}; pg8::gemm_phase<pg8::EpiSwiglu, pg8::StaticOrder, true, true>(C.lds, g, S, E); }
    SEAM(12);
    if (IN(13)) { pg8::Gemm g{WSP(pb, WS_HB), WSP(pb, WS_WF2), MT, DM, DFF}; pg8::StaticOrder S; S.init(MT, DM, C.G, C.bid);
        pg8::EpiRes E{WSP(float, WS_X), WSP(float, WS_X) + (size_t)MP * DM, WSP(float, WS_Y), ALPHA, 0.5f}; pg8::gemm_phase<pg8::EpiRes, pg8::StaticOrder, true, true>(C.lds, g, S, E); }
    SEAM(13);
    if (IN(14)) { ln_phase(C, WSP(float, WS_Y), C.in[22], C.in[23], C.out + O_YP, nullptr); }
#undef IN
#undef SEAM
}


#ifdef DEBUG_PROBE
constexpr int CW_CHK = 1024;
constexpr int N_STAGES = 19;
DI unsigned hash32(unsigned x) { x ^= x >> 16; x *= 0x7feb352dU; x ^= x >> 15; x *= 0x846ca68bU; x ^= x >> 16; return x; }
DI float dsilu(float x) { return x / (1.f + expf(-x)); }
DI float dsigm(float x) { return 1.f / (1.f + expf(-x)); }
DI int seg_start(int i) { switch (i) { case 0: return 0; case 1: return 1024; case 2: return 2048; case 3: return 4096; case 4: return 6144; case 5: return 6160; case 6: return 8208; case 7: return 8720; case 8: return 9232; case 9: return 11280; default: return 13328; } }
DI float dot_bw(const bf16* a, const float* W, int ldw, int col, int K) { float s = 0.f; for (int k = 0; k < K; ++k) s += bf2f(a[k]) * W[(size_t)k * ldw + col]; return s; }
#define WSQ(T, off) ((T*)(ws + (off)))
#define CMP(got, ref) do { const float g_ = (got), r_ = (ref); e2 += (g_ - r_) * (g_ - r_); r2 += r_ * r_; } while (0)
__global__ void __launch_bounds__(256) chk_kernel(Args args, int stage) {
    unsigned char* ws = args.ws; float* slot = (float*)(ws + WS_CTL) + CW_CHK + 2 * stage; float* out = args.out;
    const int tid = threadIdx.x, gid = blockIdx.x * 256 + tid;
    const unsigned h1 = hash32(gid * 2654435761u + stage * 977u + 12345u), h2 = hash32(h1 + 0x9e3779b9u), h3 = hash32(h2 + 0x85ebca6bu);
    float e2 = 0.f, r2 = 0.f;
    __shared__ float sh[8 * 256 * 3 + 64];
    if (stage == 1 || stage == 16) {
        const float* wi = args.in[stage == 1 ? 5 : 20]; const float* wo = args.in[stage == 1 ? 6 : 21];
        { const int n = h1 % 11264, k = h2 % 2048, pn = n >> 8, wq = n & 255, src = wq < 128 ? 128 * pn + wq : DFF + 128 * pn + wq - 128;
          CMP(bf2f(WSQ(bf16, WS_WF1)[(size_t)n * 2048 + k]), wi[(size_t)k * 11264 + src]); }
        { const int n = h2 % 2048, k = h3 % 5632; CMP(bf2f(WSQ(bf16, WS_WF2)[(size_t)n * 5632 + k]), wo[(size_t)k * 2048 + n]); }
        if (stage == 1) {
            { const int n = h3 % DINP, k = h1 % 2048; float ref = 0.f; if (n < 6144) ref = args.in[9][(size_t)k * DIN + n]; else if (n < 13312) ref = args.in[9][(size_t)k * DIN + n + 16]; else if (n < 13328) ref = args.in[9][(size_t)k * DIN + n - 13312 + 6144];
              CMP(bf2f(WSQ(bf16, WS_WIN)[(size_t)n * 2048 + k]), ref); }
            { const int n = h1 % 2048, k = h3 % 2048; CMP(bf2f(WSQ(bf16, WS_WBG)[(size_t)n * 2048 + k]), args.in[15][(size_t)k * 2048 + n]);
              CMP(bf2f(WSQ(bf16, WS_WBS)[(size_t)n * 2048 + k]), args.in[16][(size_t)k * 2048 + n]); CMP(bf2f(WSQ(bf16, WS_WO)[(size_t)n * 2048 + k]), args.in[17][(size_t)k * 2048 + n]); }
            { const int m = h2 % MT, k = h1 % 2048; const float xr = m < MP ? args.in[0][(size_t)m * DM + k] : args.in[1][(size_t)(m - MP) * DM + k]; CMP(bf2f(WSQ(bf16, WS_XB)[(size_t)m * DM + k]), xr); }
            { const int i = h3 % DINP; float ref = 0.f; if (i < 6144) ref = args.in[10][i]; else if (i < 13312) ref = args.in[10][i + 16]; else if (i < 13328) ref = args.in[10][i - 13312 + 6144]; CMP(WSQ(float, WS_BP)[i], ref); }
        }
    }
    if (stage == 2 || stage == 17) {
        const float* wi = args.in[stage == 2 ? 5 : 20]; const int m = h1 % MT, j = h2 % DFF; const bf16* a = WSQ(bf16, WS_XB) + (size_t)m * DM;
        const float g = dot_bw(a, wi, 2 * DFF, j, DM), u = dot_bw(a, wi, 2 * DFF, DFF + j, DM);
        CMP(bf2f(WSQ(bf16, WS_HB)[(size_t)m * DFF + j]), dsilu(g) * u);
    }
    if (stage == 3 || stage == 18) {
        const float* wo = args.in[stage == 3 ? 6 : 21]; const int m = h1 % MT, n = h2 % DM;
        const float xr = stage == 3 ? (m < MP ? args.in[0][(size_t)m * DM + n] : args.in[1][(size_t)(m - MP) * DM + n]) : WSQ(float, WS_X)[(size_t)m * DM + n];
        CMP(WSQ(float, WS_Y)[(size_t)m * DM + n], ALPHA * xr + 0.5f * dot_bw(WSQ(bf16, WS_HB) + (size_t)m * DFF, wo, DM, n, DFF));
    }
    if (stage == 4 || stage == 16 || stage == 19) {
        const float* lw = args.in[stage == 4 ? 7 : (stage == 16 ? 18 : 22)]; const float* lb = args.in[stage == 4 ? 8 : (stage == 16 ? 19 : 23)];
        const int m = h1 % MT; const float* y = WSQ(float, WS_Y) + (size_t)m * DM; float s = 0.f;
        for (int k = 0; k < DM; ++k) s += y[k];
        const float mean = s / DM; float q = 0.f;
        for (int k = 0; k < DM; ++k) q += (y[k] - mean) * (y[k] - mean);
        const float rstd = 1.f / sqrtf(q / DM + LN_EPS);
        for (int i = 0; i < 8; ++i) { const int n = hash32(h2 + i) % DM; const float ref = (y[n] - mean) * rstd * lw[n] + lb[n];
            if (stage == 19) CMP(out[O_YP + (size_t)m * DM + n], ref);
            else { CMP(WSQ(float, WS_X)[(size_t)m * DM + n], ref); CMP(bf2f(WSQ(bf16, WS_XB)[(size_t)m * DM + n]), ref); } }
    }
    if (stage == 5) {
        const int seg = gid % 10; const int sg0 = seg_start(seg), sg1 = seg_start(seg + 1);
        int m = h1 % MT; if ((seg == 6 || seg == 7) && (h3 & 1)) m = 8064 + h1 % (MT - 8064);
        const int n = sg0 + h2 % (sg1 - sg0), c = n - sg0;
        const float d = dot_bw(WSQ(bf16, WS_XB) + (size_t)m * DM, args.in[9], DIN, n, DM) + args.in[10][n];
        if (seg == 0) CMP(bf2f(WSQ(bf16, WS_QG)[(size_t)m * 1024 + c]), d * 0.0625f);
        if (seg == 1) CMP(bf2f(WSQ(bf16, WS_KG)[(size_t)m * 1024 + c]), d);
        if (seg == 2) CMP(bf2f(WSQ(bf16, WS_VG)[(size_t)m * 2048 + c]), d);
        if (seg == 3) CMP(bf2f(WSQ(bf16, WS_GG)[(size_t)m * 2048 + c]), dsilu(d));
        if (seg == 4) CMP(WSQ(float, WS_RG)[(size_t)m * 16 + c], d);
        if (seg == 5) CMP(bf2f(WSQ(bf16, WS_QS)[(size_t)m * 2048 + c]), d * 0.125f);
        if (seg == 6 || seg == 7) { CMP(bf2f(WSQ(bf16, seg == 6 ? WS_KS : WS_VS)[(size_t)m * 512 + c]), d);
            if (m >= MP) { const int rr = m - MP; CMP(out[(seg == 6 ? O_KS : O_VS) + ((size_t)((rr >> 3) * 128 + 120 + (rr & 7))) * 512 + c], d); }
            else if (m >= 8064) CMP(out[(seg == 6 ? O_KP : O_VP) + (size_t)(m - 8064) * 512 + c], d); }
        if (seg == 8) CMP(bf2f(WSQ(bf16, WS_SGG)[(size_t)m * 2048 + c]), dsigm(d));
        if (seg == 9) CMP(bf2f(WSQ(bf16, WS_SGS)[(size_t)m * 2048 + c]), dsigm(d));
    }
    const float* RG = WSQ(float, WS_RG); const float* wgg = args.in[11]; const float* bgg = args.in[12];
    if (stage == 6) {
        const int c = h1 % NCH, h = h2 & 3, tl = (h2 >> 2) & 63, k = (h2 >> 8) & 255, t0 = 64 * c; float run = 0.f, bt = 0.f;
        for (int tau = 0; tau < 64; ++tau) { float x = bgg[h * 256 + k]; for (int r = 0; r < 16; ++r) x += RG[(size_t)(t0 + tau) * 16 + r] * wgg[r * 1024 + h * 256 + k]; run += logsig16(x); if (tau == tl) bt = run; }
        const float q = bf2f(WSQ(bf16, WS_QG)[(size_t)(t0 + tl) * 1024 + h * 256 + k]), kk = bf2f(WSQ(bf16, WS_KG)[(size_t)(t0 + tl) * 1024 + h * 256 + k]);
        CMP(bf2f(WSQ(bf16, WS_AQ)[((size_t)(c * 4 + h) * 64 + tl) * 256 + k]), q * expf(bt));
        CMP(bf2f(WSQ(bf16, WS_KDT)[((size_t)(c * 4 + h) * 256 + k) * 64 + tl]), kk * expf(run - bt));
        CMP(WSQ(float, WS_DEC)[(c * 4 + h) * 256 + k], expf(run));
        if (gid < 128) { const int s = (h3 >> 3) & 63; float p = 0.f;
            for (int k2 = 0; k2 < 256; ++k2) { float rn = 0.f, b_t = 0.f, b_s = 0.f;
                for (int tau = 0; tau < 64; ++tau) { float x = bgg[h * 256 + k2]; for (int r = 0; r < 16; ++r) x += RG[(size_t)(t0 + tau) * 16 + r] * wgg[r * 1024 + h * 256 + k2]; rn += logsig16(x); if (tau == tl) b_t = rn; if (tau == s) b_s = rn; }
                p += bf2f(WSQ(bf16, WS_QG)[(size_t)(t0 + tl) * 1024 + h * 256 + k2]) * bf2f(WSQ(bf16, WS_KG)[(size_t)(t0 + s) * 1024 + h * 256 + k2]) * expf(b_t - b_s); }
            CMP(bf2f(WSQ(bf16, WS_PP)[((size_t)(c * 4 + h) * 64 + tl) * 64 + s]), s <= tl ? p : 0.f); }
    }
    if (stage == 7) {
        { const int c = h1 % 2048, t = h2 % 8192; CMP(bf2f(WSQ(bf16, WS_VT)[(size_t)c * 8192 + t]), bf2f(WSQ(bf16, WS_VG)[(size_t)t * 2048 + c])); }
        { const int c = h3 % 512, t = h1 % 8192; CMP(bf2f(WSQ(bf16, WS_VST)[(size_t)c * 8192 + t]), bf2f(WSQ(bf16, WS_VS)[(size_t)t * 512 + c])); }
    }
    if (stage == 8 || stage == 11) {
        const int hq = h2 & 31, kvh = hq >> 2; const float slope = exp2f(-0.25f * (float)(hq + 1)), sink = args.in[14][hq];
        int qrow, nkeys; const int b = h1 % 128, t = (h1 >> 8) & 7, tok = h1 % MP;
        if (stage == 8) { qrow = MP + 8 * b + t; nkeys = 136; } else { qrow = tok; nkeys = 128; }
        float mx = sink, den = 0.f; float o[10];
#pragma unroll
        for (int i = 0; i < 10; ++i) o[i] = 0.f;
        for (int pass = 0; pass < 2; ++pass) {
            for (int j = 0; j < nkeys; ++j) { float d = 0.f; bool valid; int dist; int kt = 0;
                if (stage == 8) { dist = 128 + t - j; valid = dist >= 0 && dist < 128;
                    for (int e = 0; e < 64; ++e) { const float kx = j < 128 ? args.in[3][((size_t)(b * 128 + j) * 8 + kvh) * 64 + e] : bf2f(WSQ(bf16, WS_KS)[(size_t)(MP + 8 * b + j - 128) * 512 + kvh * 64 + e]);
                        d += bf2f(WSQ(bf16, WS_QS)[(size_t)qrow * 2048 + hq * 64 + e]) * kx; } }
                else { kt = tok - 127 + j; dist = tok - kt; valid = kt >= 0;
                    if (valid) for (int e = 0; e < 64; ++e) d += bf2f(WSQ(bf16, WS_QS)[(size_t)qrow * 2048 + hq * 64 + e]) * bf2f(WSQ(bf16, WS_KS)[(size_t)kt * 512 + kvh * 64 + e]); }
                const float sj = d - slope * (float)dist;
                if (pass == 0) { if (valid) mx = fmaxf(mx, sj); }
                else if (valid) { const float p = expf(sj - mx); den += p;
#pragma unroll
                    for (int i = 0; i < 10; ++i) { const int e = 7 * i; float vx;
                        if (stage == 8) vx = j < 128 ? args.in[4][((size_t)(b * 128 + j) * 8 + kvh) * 64 + e] : bf2f(WSQ(bf16, WS_VS)[(size_t)(MP + 8 * b + j - 128) * 512 + kvh * 64 + e]);
                        else vx = bf2f(WSQ(bf16, WS_VS)[(size_t)kt * 512 + kvh * 64 + e]);
                        o[i] += p * vx; } } } }
        den += expf(sink - mx);
#pragma unroll
        for (int i = 0; i < 10; ++i) CMP(bf2f(WSQ(bf16, WS_OS)[(size_t)qrow * 2048 + hq * 64 + 7 * i]), o[i] / den);
        if (stage == 8) { const int j = h3 % 120, e = (h3 >> 8) & 63;
            CMP(out[O_KS + ((size_t)(b * 128 + j) * 8 + kvh) * 64 + e], args.in[3][((size_t)(b * 128 + j + 8) * 8 + kvh) * 64 + e]);
            CMP(out[O_VS + ((size_t)(b * 128 + j) * 8 + kvh) * 64 + e], args.in[4][((size_t)(b * 128 + j + 8) * 8 + kvh) * 64 + e]); }
    }
    if (stage == 9) {
        const int h = h1 & 3, k = (h1 >> 2) & 255, v = (h1 >> 10) & 511; float s = 0.f;
        for (int t = 0; t < MP; ++t) {
            if ((t & 63) == 0 && t > 0) CMP(bf2f(WSQ(bf16, WS_ST)[((size_t)((t >> 6) * 4 + h) * 512 + v) * 256 + k]), s);
            float x = bgg[h * 256 + k]; for (int r = 0; r < 16; ++r) x += RG[(size_t)t * 16 + r] * wgg[r * 1024 + h * 256 + k];
            s = expf(logsig16(x)) * s + bf2f(WSQ(bf16, WS_KG)[(size_t)t * 1024 + h * 256 + k]) * bf2f(WSQ(bf16, WS_VG)[(size_t)t * 2048 + h * 512 + v]); }
        CMP(out[O_SP + ((size_t)h * 256 + k) * 512 + v], s);
    }
    if (stage == 10) {
        const int b = hash32(blockIdx.x * 7919u + 17u) % 128, h = blockIdx.x & 3, m0 = MP + 8 * b;
        float* la = sh; float* qv = sh + 2048; float* kv = sh + 4096; float* red = sh + 6144;
        for (int i = tid; i < 2048; i += 256) { const int t = i >> 8, k = i & 255; float x = bgg[h * 256 + k]; for (int r = 0; r < 16; ++r) x += RG[(size_t)(m0 + t) * 16 + r] * wgg[r * 1024 + h * 256 + k];
            la[i] = expf(logsig16(x)); qv[i] = bf2f(WSQ(bf16, WS_QG)[(size_t)(m0 + t) * 1024 + h * 256 + k]); kv[i] = bf2f(WSQ(bf16, WS_KG)[(size_t)(m0 + t) * 1024 + h * 256 + k]); }
        __syncthreads();
        float o[2][8];
#pragma unroll
        for (int vi = 0; vi < 2; ++vi) { const int v = tid + 256 * vi; float vt[8];
#pragma unroll
            for (int t = 0; t < 8; ++t) { vt[t] = bf2f(WSQ(bf16, WS_VG)[(size_t)(m0 + t) * 2048 + h * 512 + v]); o[vi][t] = 0.f; }
            for (int k = 0; k < 256; ++k) { float s = args.in[2][((size_t)(b * 4 + h) * 256 + k) * 512 + v];
#pragma unroll
                for (int t = 0; t < 8; ++t) { s = la[t * 256 + k] * s + kv[t * 256 + k] * vt[t]; o[vi][t] += qv[t * 256 + k] * s; }
                CMP(out[O_SS + ((size_t)(b * 4 + h) * 256 + k) * 512 + v], s); } }
#pragma unroll
        for (int t = 0; t < 8; ++t) { float ss = o[0][t] * o[0][t] + o[1][t] * o[1][t]; ss = wave_sum(ss); __syncthreads(); if ((tid & 63) == 0) red[tid >> 6] = ss; __syncthreads();
            const float rs = 1.f / sqrtf((red[0] + red[1] + red[2] + red[3]) / 512.f + RMS_EPS);
#pragma unroll
            for (int vi = 0; vi < 2; ++vi) { const int v = tid + 256 * vi; const size_t off = (size_t)(m0 + t) * 2048 + h * 512 + v;
                CMP(bf2f(WSQ(bf16, WS_OG)[off]), o[vi][t] * rs * args.in[13][v] * bf2f(WSQ(bf16, WS_GG)[off])); } }
    }
    if (stage == 12) {
        const int t = hash32(blockIdx.x * 104729u + 3u) % MP, h = blockIdx.x & 3, c = t >> 6, tl = t & 63; float* red = sh; float o[2];
#pragma unroll
        for (int vi = 0; vi < 2; ++vi) { const int v = tid + 256 * vi; float s = 0.f;
            if (c > 0) for (int k = 0; k < 256; ++k) s += bf2f(WSQ(bf16, WS_AQ)[((size_t)(c * 4 + h) * 64 + tl) * 256 + k]) * bf2f(WSQ(bf16, WS_ST)[((size_t)(c * 4 + h) * 512 + v) * 256 + k]);
            for (int s2 = 0; s2 < 64; ++s2) s += bf2f(WSQ(bf16, WS_PP)[((size_t)(c * 4 + h) * 64 + tl) * 64 + s2]) * bf2f(WSQ(bf16, WS_VG)[(size_t)(64 * c + s2) * 2048 + h * 512 + v]);
            o[vi] = s; }
        float ss = o[0] * o[0] + o[1] * o[1]; ss = wave_sum(ss); if ((tid & 63) == 0) red[tid >> 6] = ss; __syncthreads();
        const float rs = 1.f / sqrtf((red[0] + red[1] + red[2] + red[3]) / 512.f + RMS_EPS);
#pragma unroll
        for (int vi = 0; vi < 2; ++vi) { const int v = tid + 256 * vi; const size_t off = (size_t)t * 2048 + h * 512 + v; CMP(bf2f(WSQ(bf16, WS_OG)[off]), o[vi] * rs * args.in[13][v] * bf2f(WSQ(bf16, WS_GG)[off])); }
    }
    if (stage == 13) { const int m = h1 % MT, n = h2 % DM;
        CMP(WSQ(float, WS_Y)[(size_t)m * DM + n], bf2f(WSQ(bf16, WS_SGG)[(size_t)m * DM + n]) * dot_bw(WSQ(bf16, WS_OG) + (size_t)m * DM, args.in[15], DM, n, DM)); }
    if (stage == 14) { const int m = h1 % MT, n = h2 % DM;
        CMP(bf2f(WSQ(bf16, WS_MG)[(size_t)m * DM + n]), WSQ(float, WS_Y)[(size_t)m * DM + n] + bf2f(WSQ(bf16, WS_SGS)[(size_t)m * DM + n]) * dot_bw(WSQ(bf16, WS_OS) + (size_t)m * DM, args.in[16], DM, n, DM)); }
    if (stage == 15) { const int m = h1 % MT, n = h2 % DM;
        CMP(WSQ(float, WS_Y)[(size_t)m * DM + n], ALPHA * WSQ(float, WS_X)[(size_t)m * DM + n] + dot_bw(WSQ(bf16, WS_MG) + (size_t)m * DM, args.in[17], DM, n, DM)); }
    atomicAdd(slot, e2); atomicAdd(slot + 1, r2);
}
__global__ void __launch_bounds__(256) report_kernel(Args args) {
    const float* slot = (const float*)(args.ws + WS_CTL) + CW_CHK; float* out = args.out;
    int s1 = 0, s2 = 0; float e1 = 0.f, e2v = 0.f, emax = 0.f;
    for (int s = 1; s <= N_STAGES; ++s) { const float err = sqrtf(slot[2 * s] / fmaxf(slot[2 * s + 1], 1e-30f)); const bool bad = !(err < 0.03f) || !(slot[2 * s + 1] > 0.f);
        if (!bad) emax = fmaxf(emax, err);
        if (bad) { const float ec = (err == err) ? fminf(err, 1.f) : 1.f; if (!s1) { s1 = s; e1 = ec; } else if (!s2) { s2 = s; e2v = ec; } } }
    const float mant1 = s1 ? 1.f + 8.f * e1 : 1.f + 8.f * fminf(1.f, emax * 10.f);
    const float R = mant1 * powf(10.f, (float)(s1 + 1));
    const float e = sqrtf((R - 0.0625f) * 16.f / 15.f);
    for (size_t i = (size_t)blockIdx.x * 256 + threadIdx.x; i < (size_t)128 * 120 * 512; i += (size_t)gridDim.x * 256) {
        const size_t b = i / (120 * 512), r = i % (120 * 512); out[O_KS + b * 128 * 512 + r] = args.in[3][b * 128 * 512 + 8 * 512 + r] * (1.f + e); }
    if (blockIdx.x == 0 && threadIdx.x == 0) out[O_SS] = sqrtf(R) * 10.f * powf(1.25f, (float)s2) * (1.f + 0.1f * e2v);
}
#endif
#ifdef PROBE_OUT
__global__ void __launch_bounds__(256) probe_kernel(Args args, size_t lo, size_t hi, float k) {
    float* out = args.out;
    for (size_t i = (size_t)blockIdx.x * 256 + threadIdx.x; i < O_END; i += (size_t)gridDim.x * 256) out[i] = (i >= lo && i < hi) ? out[i] * k : 0.f;
}
#endif

extern "C" void kernel_launch(void* const* d_in, const int* in_sizes, int n_in, void* d_out, int out_size, void* d_ws, size_t ws_size, hipStream_t stream) {
    static int grid = 0;
    if (grid == 0) {
        if (n_in != 24 || (size_t)out_size != O_END || ws_size < WS_END) { fprintf(stderr, "kernel_launch: unexpected problem: n_in %d out %d ws %zu (need %zu)\n", n_in, out_size, ws_size, (size_t)WS_END); grid = -1; return; }
        int dev = 0, cus = 0, per_cu = 0;
        if (hipGetDevice(&dev) != hipSuccess || hipDeviceGetAttribute(&cus, hipDeviceAttributeMultiprocessorCount, dev) != hipSuccess) { grid = -1; return; }
        if (hipFuncSetAttribute((const void*)hybrid_fwd, hipFuncAttributeMaxDynamicSharedMemorySize, LDS_BYTES) != hipSuccess) { fprintf(stderr, "kernel_launch: hipFuncSetAttribute failed\n"); grid = -1; return; }
        if (hipOccupancyMaxActiveBlocksPerMultiprocessor(&per_cu, (const void*)hybrid_fwd, NTHR, LDS_BYTES) != hipSuccess || per_cu < 1) { fprintf(stderr, "kernel_launch: occupancy query says %d\n", per_cu); per_cu = 1; }
        (void)hipGetLastError();
        grid = cus;
    }
    if (grid < 0) return;
    (void)hipMemsetAsync((char*)d_ws + WS_CTL, 0, CTL_ZERO_BYTES, stream);
    Args a{};
    for (int i = 0; i < 24; ++i) a.in[i] = (const float*)d_in[i];
    a.out = (float*)d_out; a.ws = (unsigned char*)d_ws;
#if defined(DEBUG_PROBE)
    { static const int chk_after[15][3] = {{1,0,0},{2,0,0},{3,0,0},{4,0,0},{5,0,0},{6,7,8},{9,10,11},{12,0,0},{13,0,0},{14,0,0},{15,0,0},{16,0,0},{17,0,0},{18,0,0},{19,0,0}};
      for (int p = 0; p < N_PHASES; ++p) { a.ph_lo = p; a.ph_hi = p + 1; hipLaunchKernelGGL(hybrid_fwd, dim3(grid), dim3(NTHR), LDS_BYTES, stream, a);
          for (int j = 0; j < 3; ++j) { const int st = chk_after[p][j]; if (!st) continue;
              int nb = 4; if (st == 1 || st == 7 || st == 16) nb = 16; if (st == 5) nb = 8; if (st == 8 || st == 11) nb = 2; if (st == 9 || st == 4 || st == 19) nb = 1; if (st == 10) nb = 8; if (st == 12) nb = 64;
              hipLaunchKernelGGL(chk_kernel, dim3(nb), dim3(256), 0, stream, a, st); } }
      (void)hipMemsetAsync(d_out, 0, (size_t)O_END * 4, stream);
      hipLaunchKernelGGL(report_kernel, dim3(256), dim3(256), 0, stream, a); }
#elif defined(PROBE_OUT)
    for (int p = 0; p < N_PHASES; ++p) { a.ph_lo = p; a.ph_hi = p + 1; hipLaunchKernelGGL(hybrid_fwd, dim3(grid), dim3(NTHR), LDS_BYTES, stream, a); }
    { const size_t ob[9] = {0, 16777216ull, O_SP, O_KP, O_VP, O_SS, O_KS, O_VS, O_END};
      hipLaunchKernelGGL(probe_kernel, dim3(2048), dim3(256), 0, stream, a, ob[PROBE_OUT], ob[PROBE_OUT + 1], (float)(PROBE_K)); }
#elif MK_N_LAUNCHES == 1
    a.ph_lo = 0; a.ph_hi = N_PHASES;
    void* kargs[] = {&a};
    hipError_t e = hipLaunchCooperativeKernel((const void*)hybrid_fwd, dim3(grid), dim3(NTHR), kargs, LDS_BYTES, stream);
    if (e != hipSuccess) fprintf(stderr, "kernel_launch: cooperative launch failed: %s (grid %d)\n", hipGetErrorString(e), grid);
#else
    for (int p = 0; p < N_PHASES; ++p) { a.ph_lo = p; a.ph_hi = p + 1; hipLaunchKernelGGL(hybrid_fwd, dim3(grid), dim3(NTHR), LDS_BYTES, stream, a); }
#endif
}
```

```cpp
#include <hip/hip_runtime.h>
#include <hip/hip_cooperative_groups.h>
#include <cstdio>
#include <cstdint>
namespace cg = cooperative_groups;
namespace pg8 {
#define PG8_LAS __attribute__((address_space(3)))
typedef unsigned short bf16_t;
typedef short bf16x8 __attribute__((ext_vector_type(8)));
typedef float f32x4 __attribute__((ext_vector_type(4)));
typedef unsigned u32x4 __attribute__((ext_vector_type(4)));
constexpr int BM = 256, BK = 64, HALF = 128, HTB = HALF * BK * 2  , STAGE_BYTES = 8 * HTB, NXCD = 8, WGM = 8;

__host__ __device__ __forceinline__ int lds_byte(int r, int c) { const int st = (r >> 4) * 2 + (c >> 5), rr = r & 15, cc = c & 31, ob = rr * 64 + cc * 2; return st * 1024 + (ob ^ (((ob >> 9) & 1) << 5)); }
__host__ __device__ __forceinline__ void stage_rc(int b, int& R, int& C) { const int st = b / 1024, sb = b % 1024, swz = sb ^ (((sb >> 9) & 1) << 5); R = (st >> 1) * 16 + swz / 64; C = (st & 1) * 32 + (swz % 64) / 2; }
__host__ __device__ __forceinline__ int perm32(int rho) { const int n = rho >> 4, i = rho & 15; return 8 * (i >> 2) + 4 * n + (i & 3); }

struct Unit { int pm, pn; };
struct Gemm { const bf16_t* A; const bf16_t* Bt; int M, N, K; };

struct StaticOrder {
    int nM, nN, nwg, G, c;
    __host__ __device__ void init(int M, int N, int G_, int c_) { nM = M / BM; nN = N / BM; nwg = nM * nN; G = G_; c = c_; }
    __host__ __device__ bool next(int i, Unit& u) const {
        const long L = (long)i * G + c; if (L >= nwg) return false;
        int wgid = (int)L; { const int q = nwg / NXCD, r = nwg % NXCD, xcd = wgid % NXCD, off = wgid / NXCD; wgid = (xcd < r ? xcd * (q + 1) : r * (q + 1) + (xcd - r) * q) + off; }
        const int nig = WGM * nN, gid = wgid / nig, fm = gid * WGM, gsz = (nM - fm) < WGM ? (nM - fm) : WGM;
        u.pm = fm + ((wgid % nig) % gsz); u.pn = (wgid % nig) / gsz; return true;
    }
    __device__ __forceinline__ void a_ready(const Unit&) const {}
    __device__ __forceinline__ void done(const Unit&) const {}
};

__device__ __forceinline__ unsigned cvt_pk_bf16(float lo, float hi) { unsigned r; asm volatile("v_cvt_pk_bf16_f32 %0, %1, %2" : "=v"(r) : "v"(lo), "v"(hi)); return r; }
typedef unsigned u32x2 __attribute__((ext_vector_type(2)));
__device__ __forceinline__ float bf_lo(unsigned w) { return __uint_as_float(w << 16); }
__device__ __forceinline__ float bf_hi(unsigned w) { return __uint_as_float(w & 0xffff0000u); }
__device__ __forceinline__ float fast_sigmoid(float x) { return __builtin_amdgcn_rcpf(1.0f + __builtin_amdgcn_exp2f(-1.44269504f * x)); }
__device__ __forceinline__ float fast_silu(float x) { return x * fast_sigmoid(x); }

struct EpiSwiglu {
    static constexpr bool PERM = true, AFTER_DRAIN = false;
    bf16_t* H; int ldh;
    __device__ __forceinline__ void operator()(const f32x4 (&acc)[2][2][4][2], const Unit& u, int wr, int wc, int fr, int fq) const {
        const int row0 = u.pm * BM + wr * 64 + fr, col0 = u.pn * 128 + wc * 32 + 8 * fq;
#pragma unroll
        for (int ai = 0; ai < 2; ++ai)
#pragma unroll
            for (int m = 0; m < 4; ++m) {
                bf16_t* rowp = H + (size_t)(row0 + ai * HALF + m * 16) * ldh + col0;
                const f32x4 g0 = acc[ai][0][m][0], g1 = acc[ai][0][m][1], u0 = acc[ai][1][m][0], u1 = acc[ai][1][m][1];
                float h[8];
#pragma unroll
                for (int j = 0; j < 4; ++j) { h[j] = fast_silu(g0[j]) * u0[j]; h[4 + j] = fast_silu(g1[j]) * u1[j]; }
                u32x4 w; w.x = cvt_pk_bf16(h[0], h[1]); w.y = cvt_pk_bf16(h[2], h[3]); w.z = cvt_pk_bf16(h[4], h[5]); w.w = cvt_pk_bf16(h[6], h[7]);
                *(u32x4*)rowp = w;
            }
    }
};

struct EpiRes {
    static constexpr bool PERM = false, AFTER_DRAIN = false;
    const float* resA; const float* resB; float* out; float alpha, scale;
    __device__ __forceinline__ void operator()(const f32x4 (&acc)[2][2][4][2], const Unit& u, int wr, int wc, int fr, int fq) const {
        const int row0 = u.pm * BM + wr * 64 + fr, col0 = u.pn * BM + wc * 32 + 4 * fq;
        const float* rbase = (u.pm < 32) ? resA + (size_t)row0 * 2048 : resB + (size_t)(row0 - 8192) * 2048;
#pragma unroll
        for (int ai = 0; ai < 2; ++ai)
#pragma unroll
            for (int m = 0; m < 4; ++m) {
                const size_t roff = (size_t)(ai * HALF + m * 16) * 2048 + col0;
                float* op = out + (size_t)row0 * 2048 + roff; const float* rp = rbase + roff;
#pragma unroll
                for (int bj = 0; bj < 2; ++bj)
#pragma unroll
                    for (int n = 0; n < 2; ++n) { const f32x4 r = *(const f32x4*)(rp + bj * HALF + n * 16); *(f32x4*)(op + bj * HALF + n * 16) = r * alpha + acc[ai][bj][m][n] * scale; }
                asm volatile("" ::: "memory");
            }
    }
};

struct EpiZ {
    static constexpr bool PERM = true, AFTER_DRAIN = false;
    bf16_t *QG, *KG, *VG, *GG, *QS, *KS, *VS, *SGG, *SGS; float* RG; const float* bias; float* out;
    __device__ __forceinline__ void operator()(const f32x4 (&acc)[2][2][4][2], const Unit& u, int wr, int wc, int fr, int fq) const {
        const int pn = u.pn; const int row0 = u.pm * BM + wr * 64 + fr; const int cl = wc * 32 + 8 * fq;
        if (pn == 52) {
            if (wc == 0 && fq < 2) {
                const f32x4 b0 = *(const f32x4*)(bias + 52 * 256 + cl), b1 = *(const f32x4*)(bias + 52 * 256 + cl + 4);
#pragma unroll
                for (int ai = 0; ai < 2; ++ai)
#pragma unroll
                    for (int m = 0; m < 4; ++m) { float* rp = RG + (size_t)(row0 + ai * HALF + m * 16) * 16 + cl;
                        *(f32x4*)rp = acc[ai][0][m][0] + b0; *(f32x4*)(rp + 4) = acc[ai][0][m][1] + b1; }
            }
            return;
        }
        bf16_t* dst; int ld, colt, mode = 0, cache = 0; float sc = 1.f;
        if (pn < 4) { dst = QG; ld = 1024; colt = pn * 256; sc = 0.0625f; }
        else if (pn < 8) { dst = KG; ld = 1024; colt = (pn - 4) * 256; }
        else if (pn < 16) { dst = VG; ld = 2048; colt = (pn - 8) * 256; }
        else if (pn < 24) { dst = GG; ld = 2048; colt = (pn - 16) * 256; mode = 1; }
        else if (pn < 32) { dst = QS; ld = 2048; colt = (pn - 24) * 256; sc = 0.125f; }
        else if (pn < 34) { dst = KS; ld = 512; colt = (pn - 32) * 256; cache = 1; }
        else if (pn < 36) { dst = VS; ld = 512; colt = (pn - 34) * 256; cache = 2; }
        else if (pn < 44) { dst = SGG; ld = 2048; colt = (pn - 36) * 256; mode = 2; }
        else { dst = SGS; ld = 2048; colt = (pn - 44) * 256; mode = 2; }
        f32x4 bv[2][2];
#pragma unroll
        for (int bj = 0; bj < 2; ++bj)
#pragma unroll
            for (int n = 0; n < 2; ++n) bv[bj][n] = *(const f32x4*)(bias + pn * 256 + bj * HALF + cl + 4 * n);
#pragma unroll
        for (int ai = 0; ai < 2; ++ai)
#pragma unroll
            for (int m = 0; m < 4; ++m) {
                const int row = row0 + ai * HALF + m * 16;
                float* cp = nullptr;
                if (cache) {
                    if (row >= 8192) { const int rr = row - 8192; cp = out + (cache == 1 ? 86638592ull : 95027200ull) + ((size_t)((rr >> 3) * 128 + 120 + (rr & 7))) * 512; }
                    else if (row >= 8064) cp = out + (cache == 1 ? 19398656ull : 19464192ull) + (size_t)(row - 8064) * 512;
                }
#pragma unroll
                for (int bj = 0; bj < 2; ++bj) {
                    f32x4 v0 = acc[ai][bj][m][0] + bv[bj][0], v1 = acc[ai][bj][m][1] + bv[bj][1];
                    const int col = colt + bj * HALF + cl;
                    if (cp) { *(f32x4*)(cp + col) = v0; *(f32x4*)(cp + col + 4) = v1; }
                    if (mode == 1) {
#pragma unroll
                        for (int j = 0; j < 4; ++j) { v0[j] = fast_silu(v0[j]); v1[j] = fast_silu(v1[j]); }
                    } else if (mode == 2) {
#pragma unroll
                        for (int j = 0; j < 4; ++j) { v0[j] = fast_sigmoid(v0[j]); v1[j] = fast_sigmoid(v1[j]); }
                    } else { v0 = v0 * sc; v1 = v1 * sc; }
                    u32x4 w; w.x = cvt_pk_bf16(v0[0], v0[1]); w.y = cvt_pk_bf16(v0[2], v0[3]); w.z = cvt_pk_bf16(v1[0], v1[1]); w.w = cvt_pk_bf16(v1[2], v1[3]);
                    *(u32x4*)(dst + (size_t)row * ld + col) = w;
                }
            }
    }
};

struct EpiGateMul {
    static constexpr bool PERM = false, AFTER_DRAIN = false;
    const bf16_t* G; float* M1;
    __device__ __forceinline__ void operator()(const f32x4 (&acc)[2][2][4][2], const Unit& u, int wr, int wc, int fr, int fq) const {
        const int row0 = u.pm * BM + wr * 64 + fr, col0 = u.pn * BM + wc * 32 + 4 * fq;
#pragma unroll
        for (int ai = 0; ai < 2; ++ai)
#pragma unroll
            for (int m = 0; m < 4; ++m) {
                const size_t off = (size_t)(row0 + ai * HALF + m * 16) * 2048 + col0;
#pragma unroll
                for (int bj = 0; bj < 2; ++bj)
#pragma unroll
                    for (int n = 0; n < 2; ++n) { const u32x2 g = *(const u32x2*)(G + off + bj * HALF + n * 16);
                        f32x4 gv = {bf_lo(g.x), bf_hi(g.x), bf_lo(g.y), bf_hi(g.y)};
                        *(f32x4*)(M1 + off + bj * HALF + n * 16) = gv * acc[ai][bj][m][n]; }
            }
    }
};

struct EpiMerge {
    static constexpr bool PERM = true, AFTER_DRAIN = false;
    const bf16_t* G; const float* M1; bf16_t* MG;
    __device__ __forceinline__ void operator()(const f32x4 (&acc)[2][2][4][2], const Unit& u, int wr, int wc, int fr, int fq) const {
        const int row0 = u.pm * BM + wr * 64 + fr, col0 = u.pn * BM + wc * 32 + 8 * fq;
#pragma unroll
        for (int ai = 0; ai < 2; ++ai)
#pragma unroll
            for (int m = 0; m < 4; ++m) {
                const size_t off = (size_t)(row0 + ai * HALF + m * 16) * 2048 + col0;
#pragma unroll
                for (int bj = 0; bj < 2; ++bj) {
                    const u32x4 g = *(const u32x4*)(G + off + bj * HALF);
                    const f32x4 ma = *(const f32x4*)(M1 + off + bj * HALF), mb = *(const f32x4*)(M1 + off + bj * HALF + 4);
                    const f32x4 g0 = {bf_lo(g.x), bf_hi(g.x), bf_lo(g.y), bf_hi(g.y)}, g1 = {bf_lo(g.z), bf_hi(g.z), bf_lo(g.w), bf_hi(g.w)};
                    const f32x4 v0 = ma + g0 * acc[ai][bj][m][0], v1 = mb + g1 * acc[ai][bj][m][1];
                    u32x4 w; w.x = cvt_pk_bf16(v0[0], v0[1]); w.y = cvt_pk_bf16(v0[2], v0[3]); w.z = cvt_pk_bf16(v1[0], v1[1]); w.w = cvt_pk_bf16(v1[2], v1[3]);
                    *(u32x4*)(MG + off + bj * HALF) = w;
                }
            }
    }
};

template <class Epi, class Sched, bool ALIGN_EPI = false, bool SP2 = false>
__device__ __forceinline__ void gemm_phase(PG8_LAS unsigned char* lds, const Gemm g, const Sched& S, const Epi& E) {
    const int tid = threadIdx.x, wid = __builtin_amdgcn_readfirstlane(tid >> 6), lane = tid & 63, wr = wid >> 2, wc = wid & 3, fr = lane & 15, fq = lane >> 4;
    const int K = g.K, nt = K / BK;
    unsigned voffA[2], voffB[2];
#pragma unroll
    for (int i = 0; i < 2; ++i) { int R, C; stage_rc(tid * 16 + i * 8192, R, C); const int Rb = Epi::PERM ? ((R & ~31) + perm32(R & 31)) : R;
        voffA[i] = (unsigned)(R * K + C) * 2u; voffB[i] = (unsigned)(Rb * K + C) * 2u; }
    const size_t kstep = (size_t)(BK * 2);
    const size_t hstep = (size_t)HALF * K * 2;
    const size_t tstep = 2 * hstep;
    const unsigned ldsw = (unsigned)wid * 1024u;
    const int aoff = lds_byte(wr * 64 + fr, fq * 8), boff = lds_byte(wc * 32 + fr, fq * 8);
#define PG8_SA(b, h) (((b) * 2 + (h)) * HTB)
#define PG8_SB(b, h) ((4 + (b) * 2 + (h)) * HTB)
#define PG8_STAGE(bufoff, gbase, voff) do { _Pragma("unroll") for (int _i = 0; _i < 2; ++_i) \
        __builtin_amdgcn_global_load_lds((const unsigned*)((const char*)(gbase) + (voff)[_i]), (PG8_LAS unsigned*)(lds + (bufoff) + ldsw + _i * 8192), 16, 0, 0); } while (0)
#define PG8_LDA(dst, b, h) do { _Pragma("unroll") for (int m = 0; m < 4; ++m) _Pragma("unroll") for (int k = 0; k < 2; ++k) dst[m][k] = *(const PG8_LAS bf16x8*)(lds + PG8_SA(b, h) + aoff + m * 2048 + k * 1024); } while (0)
#define PG8_LDB(dst, b, h) do { _Pragma("unroll") for (int n = 0; n < 2; ++n) _Pragma("unroll") for (int k = 0; k < 2; ++k) dst[n][k] = *(const PG8_LAS bf16x8*)(lds + PG8_SB(b, h) + boff + n * 2048 + k * 1024); } while (0)
#define PG8_MMA(ai, bj, At, Bt) do { __builtin_amdgcn_s_setprio(1); _Pragma("unroll") for (int m = 0; m < 4; ++m) _Pragma("unroll") for (int n = 0; n < 2; ++n) _Pragma("unroll") for (int k = 0; k < 2; ++k) \
        acc[ai][bj][m][n] = __builtin_amdgcn_mfma_f32_16x16x32_bf16(Bt[n][k], At[m][k], acc[ai][bj][m][n], 0, 0, 0); __builtin_amdgcn_s_setprio(0); } while (0)
#define PG8_WAIT_V(n) asm volatile("s_waitcnt vmcnt(" #n ")" ::: "memory")
#define PG8_WAIT_L(n) asm volatile("s_waitcnt lgkmcnt(" #n ")" ::: "memory")
#define PG8_BAR __builtin_amdgcn_s_barrier()
#define PG8_SCHED __builtin_amdgcn_sched_barrier(0)
    Unit cur, nxt; int ui = 0;
    if (!S.next(0, cur)) return;
    f32x4 acc[2][2][4][2];
#pragma unroll
    for (int a = 0; a < 2; ++a)
#pragma unroll
        for (int b = 0; b < 2; ++b)
#pragma unroll
            for (int m = 0; m < 4; ++m)
#pragma unroll
                for (int n = 0; n < 2; ++n) acc[a][b][m][n] = (f32x4){0.f, 0.f, 0.f, 0.f};
    bf16x8 At[4][2], B0[2][2], B1[2][2];
    const char* cA = (const char*)g.A + (size_t)cur.pm * tstep; const char* cB = (const char*)g.Bt + (size_t)cur.pn * tstep;
    S.a_ready(cur);
    if constexpr (SP2) {
        PG8_STAGE(PG8_SB(0, 0), cB, voffB); PG8_STAGE(PG8_SB(0, 1), cB + hstep, voffB); PG8_STAGE(PG8_SA(0, 0), cA, voffA); PG8_STAGE(PG8_SA(0, 1), cA + hstep, voffA);
        if (wr == 1) PG8_BAR;
        PG8_WAIT_V(2); PG8_BAR;
        PG8_STAGE(PG8_SB(1, 0), cB + kstep, voffB); PG8_STAGE(PG8_SA(1, 0), cA + kstep, voffA); PG8_STAGE(PG8_SB(1, 1), cB + hstep + kstep, voffB);
        PG8_WAIT_V(6); PG8_BAR;
    } else {
        PG8_STAGE(PG8_SB(0, 0), cB, voffB); PG8_STAGE(PG8_SA(0, 0), cA, voffA); PG8_STAGE(PG8_SB(0, 1), cB + hstep, voffB); PG8_STAGE(PG8_SA(0, 1), cA + hstep, voffA);
        if (wr == 1) PG8_BAR;
        PG8_WAIT_V(4); PG8_BAR;
        PG8_STAGE(PG8_SB(1, 0), cB + kstep, voffB); PG8_STAGE(PG8_SA(1, 0), cA + kstep, voffA); PG8_STAGE(PG8_SB(1, 1), cB + hstep + kstep, voffB);
        PG8_WAIT_V(6); PG8_BAR;
    }
    for (;;) {
        const bool has_next = S.next(ui + 1, nxt);
        const char* nA = has_next ? (const char*)g.A + (size_t)nxt.pm * tstep : cA; const char* nB = has_next ? (const char*)g.Bt + (size_t)nxt.pn * tstep : cB;
        for (int t = 0; t < nt; t += 2) {
            const bool last = (t == nt - 2);
            const char* a1 = cA + (size_t)(t + 1) * kstep;
            const char* a2 = last ? nA : cA + (size_t)(t + 2) * kstep; const char* b2 = last ? nB : cB + (size_t)(t + 2) * kstep;
            const char* a3 = a2 + kstep; const char* b3 = b2 + kstep;
            if (last && has_next) S.a_ready(nxt);
            if constexpr (SP2) {
            PG8_LDB(B0, 0, 0); PG8_LDB(B1, 0, 1); PG8_SCHED; PG8_LDA(At, 0, 0); PG8_STAGE(PG8_SA(1, 1), a1 + hstep, voffA);
            PG8_WAIT_V(8); PG8_WAIT_L(0); PG8_BAR; PG8_MMA(0, 0, At, B0); PG8_MMA(0, 1, At, B1); PG8_BAR; PG8_SCHED;
            PG8_LDA(At, 0, 1); PG8_STAGE(PG8_SB(0, 0), b2, voffB); PG8_STAGE(PG8_SB(0, 1), b2 + hstep, voffB); PG8_STAGE(PG8_SA(0, 0), a2, voffA);
            PG8_WAIT_V(8); PG8_WAIT_L(0); PG8_BAR; PG8_MMA(1, 0, At, B0); PG8_MMA(1, 1, At, B1); PG8_BAR; PG8_SCHED;
            PG8_LDB(B0, 1, 0); PG8_LDB(B1, 1, 1); PG8_SCHED; PG8_LDA(At, 1, 0); PG8_STAGE(PG8_SA(0, 1), a2 + hstep, voffA);
            PG8_WAIT_V(8); PG8_WAIT_L(0); PG8_BAR; PG8_MMA(0, 0, At, B0); PG8_MMA(0, 1, At, B1); PG8_BAR; PG8_SCHED;
            PG8_LDA(At, 1, 1); PG8_STAGE(PG8_SB(1, 0), b3, voffB); PG8_STAGE(PG8_SB(1, 1), b3 + hstep, voffB); PG8_STAGE(PG8_SA(1, 0), a3, voffA);
            PG8_WAIT_V(8); PG8_WAIT_L(0); PG8_BAR; PG8_MMA(1, 0, At, B0); PG8_MMA(1, 1, At, B1); PG8_BAR; PG8_SCHED;
            } else {
            PG8_LDB(B0, 0, 0); PG8_SCHED; PG8_LDA(At, 0, 0); PG8_STAGE(PG8_SA(1, 1), a1 + hstep, voffA);
            PG8_WAIT_L(8); PG8_BAR; PG8_WAIT_L(0); PG8_MMA(0, 0, At, B0); PG8_BAR; PG8_SCHED;
            PG8_LDB(B1, 0, 1); PG8_STAGE(PG8_SB(0, 0), b2, voffB);
            PG8_BAR; PG8_WAIT_L(0); PG8_MMA(0, 1, At, B1); PG8_BAR;
            PG8_LDA(At, 0, 1); PG8_STAGE(PG8_SA(0, 0), a2, voffA);
            PG8_BAR; PG8_WAIT_L(0); PG8_MMA(1, 0, At, B0); PG8_BAR; PG8_SCHED;
            PG8_STAGE(PG8_SB(0, 1), b2 + hstep, voffB);
            PG8_WAIT_V(6); PG8_BAR; PG8_MMA(1, 1, At, B1); PG8_BAR;
            PG8_LDB(B0, 1, 0); PG8_SCHED; PG8_LDA(At, 1, 0); PG8_STAGE(PG8_SA(0, 1), a2 + hstep, voffA);
            PG8_WAIT_L(8); PG8_BAR; PG8_WAIT_L(0); PG8_MMA(0, 0, At, B0); PG8_BAR; PG8_SCHED;
            PG8_LDB(B1, 1, 1); PG8_STAGE(PG8_SB(1, 0), b3, voffB);
            PG8_BAR; PG8_WAIT_L(0); PG8_MMA(0, 1, At, B1); PG8_BAR;
            PG8_LDA(At, 1, 1); PG8_STAGE(PG8_SA(1, 0), a3, voffA);
            PG8_BAR; PG8_WAIT_L(0); PG8_MMA(1, 0, At, B0); PG8_BAR; PG8_SCHED;
            PG8_STAGE(PG8_SB(1, 1), b3 + hstep, voffB);
            PG8_WAIT_V(6); PG8_BAR; PG8_MMA(1, 1, At, B1); PG8_BAR;
            }
        }
        if constexpr (ALIGN_EPI) { if (wr == 0) PG8_BAR; }
        if constexpr (!Epi::AFTER_DRAIN) { E(acc, cur, wr, wc, fr, fq); S.done(cur); }
        if (!has_next) break;
#pragma unroll
        for (int a = 0; a < 2; ++a)
#pragma unroll
            for (int b = 0; b < 2; ++b)
#pragma unroll
                for (int m = 0; m < 4; ++m)
#pragma unroll
                    for (int n = 0; n < 2; ++n) acc[a][b][m][n] = (f32x4){0.f, 0.f, 0.f, 0.f};
        cur = nxt; cA = nA; cB = nB; ++ui;
        if constexpr (ALIGN_EPI) { if (wr == 1) PG8_BAR; }
    }
    PG8_WAIT_V(0);
    if constexpr (!ALIGN_EPI) { if (wr == 0) PG8_BAR; }
    PG8_BAR;
    if constexpr (Epi::AFTER_DRAIN) { E.fused(acc, cur, wr, wc, fr, fq, lds, wid, lane); S.done(cur); }
#undef PG8_SA
#undef PG8_SB
#undef PG8_STAGE
#undef PG8_LDA
#undef PG8_LDB
#undef PG8_MMA
#undef PG8_WAIT_V
#undef PG8_WAIT_L
#undef PG8_BAR
#undef PG8_SCHED
}
}

#define DI __device__ __forceinline__
#define LAS __attribute__((address_space(3)))
typedef unsigned short bf16;
typedef short bf16x8 __attribute__((ext_vector_type(8)));
typedef float f32x4 __attribute__((ext_vector_type(4)));
typedef float f32x16 __attribute__((ext_vector_type(16)));
typedef unsigned u32x4 __attribute__((ext_vector_type(4)));
typedef unsigned u32x2 __attribute__((ext_vector_type(2)));
typedef __bf16 bf16x2_t __attribute__((ext_vector_type(2)));
typedef float f32x2_t __attribute__((ext_vector_type(2)));

constexpr int NWAVES = 8, NTHR = 512;
constexpr int DM = 2048, MP = 8192, MS = 1024, MT = 9216, DFF = 5632, DIN = 13328, DINP = 13568;
constexpr int NCH = 128;
constexpr float ALPHA = 1.189207115002721f;
constexpr float LN_EPS = 1e-5f, RMS_EPS = 1e-6f;
constexpr size_t O_YP = 0, O_SP = 18874368ull, O_KP = 19398656ull, O_VP = 19464192ull, O_SS = 19529728ull, O_KS = 86638592ull, O_VS = 95027200ull, O_END = 103415808ull;
constexpr size_t MiB = 1ull << 20;
constexpr size_t WS_CTL = 0, CTL_ZERO_BYTES = 1 * MiB;
constexpr size_t WS_WF1 = 1 * MiB, WS_WF2 = 45 * MiB, WS_WIN = 67 * MiB, WS_WBG = 120 * MiB, WS_WBS = 128 * MiB, WS_WO = 136 * MiB, WS_BP = 144 * MiB;
constexpr size_t WS_XB = 145 * MiB, WS_HB = 181 * MiB, WS_ST = 181 * MiB, WS_Y = 309 * MiB, WS_X = 381 * MiB;
constexpr size_t WS_QG = 453 * MiB, WS_KG = 471 * MiB, WS_VG = 489 * MiB, WS_GG = 525 * MiB, WS_QS = 561 * MiB, WS_KS = 597 * MiB, WS_VS = 606 * MiB;
constexpr size_t WS_SGG = 615 * MiB, WS_SGS = 651 * MiB, WS_RG = 687 * MiB, WS_AQ = 688 * MiB, WS_KDT = 704 * MiB, WS_PP = 720 * MiB, WS_DEC = 724 * MiB;
constexpr size_t WS_VT = 725 * MiB, WS_VST = 757 * MiB, WS_OG = 765 * MiB, WS_OS = 801 * MiB, WS_MG = 837 * MiB, WS_END = 873 * MiB;
constexpr int CW_QUEUE = 64;
constexpr int LDS_BYTES = 147456;
constexpr int LDS_MISC = 143360;

DI float bf2f(unsigned short b) { return __uint_as_float((unsigned)b << 16); }
DI float bflo(unsigned w) { return __uint_as_float(w << 16); }
DI float bfhi(unsigned w) { return __uint_as_float(w & 0xffff0000u); }
DI unsigned pk2(float lo, float hi) { f32x2_t v = {lo, hi}; bf16x2_t b = __builtin_convertvector(v, bf16x2_t); return __builtin_bit_cast(unsigned, b); }
DI unsigned short f2bf(float f) { return (unsigned short)(pk2(f, 0.f) & 0xffffu); }
DI float wave_sum(float v) {
#pragma unroll
    for (int o = 1; o < 64; o <<= 1) v += __shfl_xor(v, o);
    return v;
}
DI float logsig16(float x) { return (fminf(x, 0.f) - log1pf(__expf(-fabsf(x)))) * 0.0625f; }
#define MFMA32(a, b, c) __builtin_amdgcn_mfma_f32_32x32x16_bf16((a), (b), (c), 0, 0, 0)
#define MFMA16(a, b, c) __builtin_amdgcn_mfma_f32_16x16x32_bf16((a), (b), (c), 0, 0, 0)
#define LDS_WAIT() asm volatile("s_waitcnt lgkmcnt(0)" ::: "memory")

struct Args { const float* in[24]; float* out; unsigned char* ws; int ph_lo, ph_hi; };

struct Ctx {
    LAS unsigned char* lds; int tid, lane, wave, G, bid;
    const float* const* in; float* out; unsigned char* ws;
};
#define WSP(T, off) ((T*)(C.ws + (off)))

DI void transpose_item(const float* W, int ldw, int k0, int n_src0, int nvalid, bf16* WT, int K, int dst_row0, LAS float* scr, int lane) {
    const int c = lane & 31;
#pragma unroll 8
    for (int i = 0; i < 32; ++i) { const int kk = 2 * i + (lane >> 5); float v = 0.f; if (c < nvalid) v = W[(size_t)(k0 + kk) * ldw + n_src0 + c]; scr[kk * 33 + c] = v; }
    LDS_WAIT(); asm volatile("" ::: "memory");
    const int c8 = lane & 7;
#pragma unroll
    for (int j = 0; j < 4; ++j) { const int n = (lane >> 3) + 8 * j; const LAS float* s = scr + (8 * c8) * 33 + n;
        u32x4 o; o.x = pk2(s[0 * 33], s[1 * 33]); o.y = pk2(s[2 * 33], s[3 * 33]); o.z = pk2(s[4 * 33], s[5 * 33]); o.w = pk2(s[6 * 33], s[7 * 33]);
        *(u32x4*)(WT + (size_t)(dst_row0 + n) * K + k0 + 8 * c8) = o; }
    LDS_WAIT(); asm volatile("" ::: "memory");
}
DI void conv_ffn(const Ctx& C, const float* w_in_, const float* w_out_) {
    LAS float* scr = (LAS float*)(C.lds + C.wave * 16384);
    const int gw = C.bid * NWAVES + C.wave, NGW = C.G * NWAVES;
    bf16* W1T = WSP(bf16, WS_WF1); bf16* W1OT = WSP(bf16, WS_WF2);
    constexpr int I1 = 32 * 352, I2 = 88 * 64;
    for (int it = gw; it < I1 + I2; it += NGW) {
        if (it < I1) { const int kb = it / 352, nb = it % 352, nd = 32 * nb, pn = nd >> 8, wi = nd & 255;
            const int src = (wi < 128) ? 128 * pn + wi : DFF + 128 * pn + (wi - 128);
            transpose_item(w_in_, 2 * DFF, 64 * kb, src, 32, W1T, DM, nd, scr, C.lane); }
        else { const int r = it - I1, kb = r / 64, nb = r % 64;
            transpose_item(w_out_, DM, 64 * kb, 32 * nb, 32, W1OT, DFF, 32 * nb, scr, C.lane); }
    }
}
DI void p0_prologue(const Ctx& C) {
    LAS float* scr = (LAS float*)(C.lds + C.wave * 16384);
    const int gw = C.bid * NWAVES + C.wave, NGW = C.G * NWAVES;
    conv_ffn(C, C.in[5], C.in[6]);
    bf16* WINT = WSP(bf16, WS_WIN);
    constexpr int I3 = 32 * 424, I4 = 32 * 64;
    for (int it = gw; it < I3 + 3 * I4; it += NGW) {
        if (it < I3) { const int kb = it / 424, nb = it % 424, nd = 32 * nb; int src = 0, nv = 32;
            if (nd < 6144) src = nd; else if (nd < 13312) src = nd + 16; else if (nd == 13312) { src = 6144; nv = 16; } else nv = 0;
            transpose_item(C.in[9], DIN, 64 * kb, src, nv, WINT, DM, nd, scr, C.lane); }
        else { int r = it - I3; const int which = r / I4; r -= which * I4; const int kb = r / 64, nb = r % 64;
            const float* W = C.in[15 + which]; bf16* WT = WSP(bf16, which == 0 ? WS_WBG : (which == 1 ? WS_WBS : WS_WO));
            transpose_item(W, DM, 64 * kb, 32 * nb, 32, WT, DM, 32 * nb, scr, C.lane); }
    }
    bf16* XB = WSP(bf16, WS_XB);
    for (int m = gw; m < MT; m += NGW) {
        const float* xr = (m < MP) ? C.in[0] + (size_t)m * DM : C.in[1] + (size_t)(m - MP) * DM;
        const f32x4* x4 = (const f32x4*)xr + C.lane; u32x2* o = (u32x2*)(XB + (size_t)m * DM) + C.lane;
#pragma unroll
        for (int j = 0; j < 8; ++j) { const f32x4 v = x4[64 * j]; u32x2 w; w.x = pk2(v.x, v.y); w.y = pk2(v.z, v.w); o[64 * j] = w; }
    }
    float* BP = WSP(float, WS_BP); const float* b_in = C.in[10];
    for (int i = C.bid * NTHR + C.tid; i < DINP; i += C.G * NTHR) {
        float v = 0.f; if (i < 6144) v = b_in[i]; else if (i < 13312) v = b_in[i + 16]; else if (i < 13328) v = b_in[i - 13312 + 6144];
        BP[i] = v; }
}
DI void ln_phase(const Ctx& C, const float* Y, const float* w, const float* b, float* Xf, bf16* XB) {
    const int gw = C.bid * NWAVES + C.wave, NGW = C.G * NWAVES;
    for (int m = gw; m < MT; m += NGW) {
        const f32x4* y4 = (const f32x4*)(Y + (size_t)m * DM) + C.lane;
        f32x4 v[8]; float s = 0.f;
#pragma unroll
        for (int j = 0; j < 8; ++j) { v[j] = y4[64 * j]; s += (v[j].x + v[j].y) + (v[j].z + v[j].w); }
        const float mean = wave_sum(s) * (1.f / DM); float s2 = 0.f;
#pragma unroll
        for (int j = 0; j < 8; ++j) { v[j] = v[j] - mean; s2 += (v[j].x * v[j].x + v[j].y * v[j].y) + (v[j].z * v[j].z + v[j].w * v[j].w); }
        const float rstd = 1.f / sqrtf(wave_sum(s2) * (1.f / DM) + LN_EPS);
        const f32x4* w4 = (const f32x4*)w + C.lane; const f32x4* b4 = (const f32x4*)b + C.lane;
#pragma unroll
        for (int j = 0; j < 8; ++j) { const f32x4 o = v[j] * rstd * w4[64 * j] + b4[64 * j];
            if (Xf) ((f32x4*)(Xf + (size_t)m * DM) + C.lane)[64 * j] = o;
            if (XB) { u32x2 p; p.x = pk2(o.x, o.y); p.y = pk2(o.z, o.w); ((u32x2*)(XB + (size_t)m * DM) + C.lane)[64 * j] = p; } }
    }
}

DI void g1_item(const Ctx& C, int item) {
    const int c = item >> 2, h = item & 3, tid = C.tid, lane = C.lane, w = C.wave;
    LAS float* rgs = (LAS float*)(C.lds);
    LAS float* tot = (LAS float*)(C.lds + 4096);
    LAS unsigned short* sAq = (LAS unsigned short*)(C.lds + 8192);
    LAS unsigned short* sBk = (LAS unsigned short*)(C.lds + 8192 + 33792);
    const float* RG = WSP(float, WS_RG); const bf16* QG = WSP(bf16, WS_QG); const bf16* KG = WSP(bf16, WS_KG);
    bf16* AQ = WSP(bf16, WS_AQ); bf16* KDT = WSP(bf16, WS_KDT); bf16* PP = WSP(bf16, WS_PP); float* DEC = WSP(float, WS_DEC);
    const int t0 = c * 64;
    for (int i = tid; i < 64 * 16; i += NTHR) rgs[i] = RG[(size_t)t0 * 16 + i];
    const int k = tid & 255, half = tid >> 8;
    float wg[16];
#pragma unroll
    for (int r = 0; r < 16; ++r) wg[r] = C.in[11][r * 1024 + h * 256 + k];
    const float bias = C.in[12][h * 256 + k];
    __syncthreads();
    float run = 0.f;
    for (int tt = 0; tt < 32; ++tt) { const int t = half * 32 + tt; float x = bias;
#pragma unroll
        for (int r = 0; r < 16; ++r) x += rgs[t * 16 + r] * wg[r];
        run += logsig16(x); }
    tot[half * 256 + k] = run;
    __syncthreads();
    const float t0s = tot[k], t1s = tot[256 + k];
    const float bl = t0s + t1s; run = half ? t0s : 0.f;
    unsigned kdp[16];
#pragma unroll
    for (int tp = 0; tp < 16; ++tp) {
        float kd2[2];
#pragma unroll
        for (int e = 0; e < 2; ++e) { const int t = half * 32 + 2 * tp + e; float x = bias;
#pragma unroll
            for (int r = 0; r < 16; ++r) x += rgs[t * 16 + r] * wg[r];
            run += logsig16(x);
            const float q = bf2f(QG[(size_t)(t0 + t) * 1024 + h * 256 + k]), kk = bf2f(KG[(size_t)(t0 + t) * 1024 + h * 256 + k]);
            sAq[t * 264 + k] = f2bf(q * __expf(run)); sBk[t * 264 + k] = f2bf(kk * __expf(-run)); kd2[e] = kk * __expf(bl - run); }
        kdp[tp] = pk2(kd2[0], kd2[1]);
    }
    { u32x4* dst = (u32x4*)(KDT + ((size_t)(c * 4 + h) * 256 + k) * 64 + half * 32);
#pragma unroll
      for (int i = 0; i < 4; ++i) { u32x4 v; v.x = kdp[4 * i]; v.y = kdp[4 * i + 1]; v.z = kdp[4 * i + 2]; v.w = kdp[4 * i + 3]; dst[i] = v; } }
    if (half == 0) DEC[(c * 4 + h) * 256 + k] = __expf(bl);
    __syncthreads();
#pragma unroll
    for (int i = 0; i < 4; ++i) { const int idx = tid + NTHR * i, row = idx >> 5, ch = idx & 31;
        const u32x4 v = *(const LAS u32x4*)(sAq + row * 264 + ch * 8); *(u32x4*)(AQ + ((size_t)(c * 4 + h) * 64 + row) * 256 + ch * 8) = v; }
    { const int mt = w >> 1, fr = lane & 15, fq = lane >> 4;
#pragma unroll
      for (int nn = 0; nn < 2; ++nn) { const int nt = 2 * (w & 1) + nn; f32x4 acc = {0.f, 0.f, 0.f, 0.f};
          if (nt <= mt) {
#pragma unroll
              for (int ks = 0; ks < 8; ++ks) { const bf16x8 a = *(const LAS bf16x8*)(sBk + (16 * nt + fr) * 264 + 32 * ks + 8 * fq);
                  const bf16x8 b = *(const LAS bf16x8*)(sAq + (16 * mt + fr) * 264 + 32 * ks + 8 * fq); acc = MFMA16(a, b, acc); } }
          const int t = 16 * mt + fr, s0 = 16 * nt + 4 * fq;
          u32x2 o; o.x = pk2(s0 <= t ? acc[0] : 0.f, s0 + 1 <= t ? acc[1] : 0.f); o.y = pk2(s0 + 2 <= t ? acc[2] : 0.f, s0 + 3 <= t ? acc[3] : 0.f);
          *(u32x2*)(PP + ((size_t)(c * 4 + h) * 64 + t) * 64 + s0) = o; } }
    __syncthreads();
}
DI void tr_item(const bf16* src, int ldc, bf16* dst, int item, LAS unsigned short* scr, int lane) {
    const int ncb = ldc / 32, tb = item / ncb, cb = item % ncb, t0 = 64 * tb, c0 = 32 * cb;
#pragma unroll
    for (int i = 0; i < 8; ++i) { const int row = 8 * i + (lane >> 3), ch = lane & 7;
        const u32x2 v = *(const u32x2*)(src + (size_t)(t0 + row) * ldc + c0 + 4 * ch); *(LAS u32x2*)(scr + row * 36 + 4 * ch) = v; }
    LDS_WAIT(); asm volatile("" ::: "memory");
    const int cc = lane & 31, th = lane >> 5; unsigned pw[16];
#pragma unroll
    for (int j = 0; j < 16; ++j) { const unsigned lo = scr[(32 * th + 2 * j) * 36 + cc], hi = scr[(32 * th + 2 * j + 1) * 36 + cc]; pw[j] = lo | (hi << 16); }
    u32x4* d = (u32x4*)(dst + (size_t)(c0 + cc) * 8192 + t0 + 32 * th);
#pragma unroll
    for (int i = 0; i < 4; ++i) { u32x4 v; v.x = pw[4 * i]; v.y = pw[4 * i + 1]; v.z = pw[4 * i + 2]; v.w = pw[4 * i + 3]; d[i] = v; }
    LDS_WAIT(); asm volatile("" ::: "memory");
}
DI void g2_item(const Ctx& C, int item) {
    const int h = item >> 4, vs = item & 15, w = C.wave, r = C.lane & 31, hh = C.lane >> 5;
    const bf16* KDT = WSP(bf16, WS_KDT); const bf16* VT = WSP(bf16, WS_VT); const float* DEC = WSP(float, WS_DEC); bf16* ST = WSP(bf16, WS_ST);
    const bf16* Ap = KDT + ((size_t)h * 256 + 32 * w + r) * 64 + 8 * hh;
    const bf16* Bp = VT + (size_t)(h * 512 + 32 * vs + r) * 8192 + 8 * hh;
    const float* Dp = DEC + h * 256 + 32 * w + 4 * hh;
    f32x16 S;
#pragma unroll
    for (int i = 0; i < 16; ++i) S[i] = 0.f;
    bf16x8 a[4], b[4]; f32x4 d[4];
#pragma unroll
    for (int ks = 0; ks < 4; ++ks) { a[ks] = *(const bf16x8*)(Ap + 16 * ks); b[ks] = *(const bf16x8*)(Bp + 16 * ks); d[ks] = *(const f32x4*)(Dp + 8 * ks); }
    for (int c = 0; c < NCH; ++c) {
        if (c > 0) { bf16* sp = ST + ((size_t)(c * 4 + h) * 512 + 32 * vs + r) * 256 + 32 * w + 4 * hh;
#pragma unroll
            for (int q = 0; q < 4; ++q) { u32x2 o; o.x = pk2(S[4 * q], S[4 * q + 1]); o.y = pk2(S[4 * q + 2], S[4 * q + 3]); *(u32x2*)(sp + 8 * q) = o; } }
        bf16x8 an[4], bn[4]; f32x4 dn[4];
        const int cn = (c + 1 < NCH) ? c + 1 : c;
#pragma unroll
        for (int ks = 0; ks < 4; ++ks) { an[ks] = *(const bf16x8*)(Ap + (size_t)cn * (4 * 256 * 64) + 16 * ks); bn[ks] = *(const bf16x8*)(Bp + 64 * cn + 16 * ks); dn[ks] = *(const f32x4*)(Dp + cn * 1024 + 8 * ks); }
#pragma unroll
        for (int q = 0; q < 4; ++q)
#pragma unroll
            for (int j = 0; j < 4; ++j) S[4 * q + j] *= d[q][j];
#pragma unroll
        for (int ks = 0; ks < 4; ++ks) S = MFMA32(a[ks], b[ks], S);
#pragma unroll
        for (int ks = 0; ks < 4; ++ks) { a[ks] = an[ks]; b[ks] = bn[ks]; d[ks] = dn[ks]; }
    }
    float* so = C.out + O_SP + ((size_t)h * 256 + 32 * w + 4 * hh) * 512 + 32 * vs + r;
#pragma unroll
    for (int q = 0; q < 4; ++q)
#pragma unroll
        for (int j = 0; j < 4; ++j) so[(size_t)(8 * q + j) * 512] = S[4 * q + j];
}
DI void g3_item(const Ctx& C, int item) {
    const int c = item >> 2, h = item & 3, w = C.wave, r = C.lane & 31, hh = C.lane >> 5, v0 = 64 * w;
    const bf16* ST = WSP(bf16, WS_ST); const bf16* AQ = WSP(bf16, WS_AQ); const bf16* PP = WSP(bf16, WS_PP); const bf16* VT = WSP(bf16, WS_VT);
    const bf16* GG = WSP(bf16, WS_GG); bf16* OG = WSP(bf16, WS_OG);
    LAS float* red = (LAS float*)(C.lds);
    f32x16 acc[2][2];
#pragma unroll
    for (int i = 0; i < 2; ++i)
#pragma unroll
        for (int j = 0; j < 2; ++j)
#pragma unroll
            for (int e = 0; e < 16; ++e) acc[i][j][e] = 0.f;
    if (c > 0) {
        const bf16* ap = ST + ((size_t)(c * 4 + h) * 512 + v0 + r) * 256 + 8 * hh;
        const bf16* bp = AQ + ((size_t)(c * 4 + h) * 64 + r) * 256 + 8 * hh;
#pragma unroll 4
        for (int ks = 0; ks < 16; ++ks) {
            const bf16x8 a0 = *(const bf16x8*)(ap + 16 * ks), a1 = *(const bf16x8*)(ap + 32 * 256 + 16 * ks);
            const bf16x8 b0 = *(const bf16x8*)(bp + 16 * ks), b1 = *(const bf16x8*)(bp + 32 * 256 + 16 * ks);
            acc[0][0] = MFMA32(a0, b0, acc[0][0]); acc[0][1] = MFMA32(a0, b1, acc[0][1]); acc[1][0] = MFMA32(a1, b0, acc[1][0]); acc[1][1] = MFMA32(a1, b1, acc[1][1]); }
    }
    { const bf16* ap = VT + (size_t)(h * 512 + v0 + r) * 8192 + 64 * c + 8 * hh;
      const bf16* bp = PP + ((size_t)(c * 4 + h) * 64 + r) * 64 + 8 * hh;
#pragma unroll
      for (int ks = 0; ks < 4; ++ks) {
          const bf16x8 a0 = *(const bf16x8*)(ap + 16 * ks), a1 = *(const bf16x8*)(ap + (size_t)32 * 8192 + 16 * ks);
          const bf16x8 b0 = *(const bf16x8*)(bp + 16 * ks), b1 = *(const bf16x8*)(bp + 32 * 64 + 16 * ks);
          acc[0][0] = MFMA32(a0, b0, acc[0][0]); acc[0][1] = MFMA32(a0, b1, acc[0][1]); acc[1][0] = MFMA32(a1, b0, acc[1][0]); acc[1][1] = MFMA32(a1, b1, acc[1][1]); } }
#pragma unroll
    for (int nt = 0; nt < 2; ++nt) { float s = 0.f;
#pragma unroll
        for (int mv = 0; mv < 2; ++mv)
#pragma unroll
            for (int e = 0; e < 16; ++e) s += acc[mv][nt][e] * acc[mv][nt][e];
        s += __shfl_xor(s, 32);
        if (hh == 0) red[w * 64 + 32 * nt + r] = s; }
    __syncthreads();
    const float* nw = C.in[13];
#pragma unroll
    for (int nt = 0; nt < 2; ++nt) { float tot = 0.f;
#pragma unroll
        for (int ww = 0; ww < 8; ++ww) tot += red[ww * 64 + 32 * nt + r];
        const float rs = 1.f / sqrtf(tot * (1.f / 512.f) + RMS_EPS);
        const size_t rowoff = (size_t)(64 * c + 32 * nt + r) * 2048 + h * 512;
#pragma unroll
        for (int mv = 0; mv < 2; ++mv)
#pragma unroll
            for (int q = 0; q < 4; ++q) { const int v = v0 + 32 * mv + 8 * q + 4 * hh;
                const f32x4 n4 = *(const f32x4*)(nw + v); const u32x2 g = *(const u32x2*)(GG + rowoff + v);
                u32x2 o; o.x = pk2(acc[mv][nt][4 * q] * rs * n4.x * bflo(g.x), acc[mv][nt][4 * q + 1] * rs * n4.y * bfhi(g.x));
                o.y = pk2(acc[mv][nt][4 * q + 2] * rs * n4.z * bflo(g.y), acc[mv][nt][4 * q + 3] * rs * n4.w * bfhi(g.y));
                *(u32x2*)(OG + rowoff + v) = o; } }
    __syncthreads();
}
DI void dgla_item(const Ctx& C, int item) {
    const int b = item >> 2, h = item & 3, tid = C.tid, lane = C.lane, w = C.wave, m0 = MP + 8 * b;
    LAS float* sAq = (LAS float*)(C.lds);
    LAS float* sKd = (LAS float*)(C.lds + 8192);
    LAS float* sDec = (LAS float*)(C.lds + 16384);
    LAS float* sB = (LAS float*)(C.lds + 17408);
    LAS float* sQ = (LAS float*)(C.lds + 25600);
    LAS float* sK = (LAS float*)(C.lds + 33792);
    LAS float* sSc = (LAS float*)(C.lds + 41984);
    LAS float* sSs = (LAS float*)(C.lds + 42240);
    LAS float* red = (LAS float*)(C.lds + 43008);
    const float* RG = WSP(float, WS_RG); const bf16* QG = WSP(bf16, WS_QG); const bf16* KG = WSP(bf16, WS_KG); const bf16* VG = WSP(bf16, WS_VG);
    const bf16* GG = WSP(bf16, WS_GG); bf16* OG = WSP(bf16, WS_OG);
    if (tid < 256) { const int k = tid; float wg[16];
#pragma unroll
        for (int r = 0; r < 16; ++r) wg[r] = C.in[11][r * 1024 + h * 256 + k];
        const float bias = C.in[12][h * 256 + k]; float bb[8], qq[8], kk[8]; float run = 0.f;
#pragma unroll
        for (int t = 0; t < 8; ++t) { float x = bias;
#pragma unroll
            for (int r = 0; r < 16; ++r) x += RG[(size_t)(m0 + t) * 16 + r] * wg[r];
            run += logsig16(x); bb[t] = run; qq[t] = bf2f(QG[(size_t)(m0 + t) * 1024 + h * 256 + k]); kk[t] = bf2f(KG[(size_t)(m0 + t) * 1024 + h * 256 + k]);
            sB[t * 256 + k] = run; sQ[t * 256 + k] = qq[t]; sK[t * 256 + k] = kk[t]; }
#pragma unroll
        for (int t = 0; t < 8; ++t) { sAq[k * 8 + t] = qq[t] * __expf(bb[t]); sKd[k * 8 + t] = kk[t] * __expf(bb[7] - bb[t]); }
        sDec[k] = __expf(bb[7]); }
    __syncthreads();
    { const int t = w;
      for (int s = 0; s < 8; ++s) { float p = 0.f;
          if (s <= t) {
#pragma unroll
              for (int i = 0; i < 4; ++i) { const int k = lane + 64 * i; p += sQ[t * 256 + k] * sK[s * 256 + k] * __expf(sB[t * 256 + k] - sB[s * 256 + k]); }
              p = wave_sum(p); }
          if (lane == 0) sSc[t * 8 + s] = p; } }
    const int v4 = tid & 127, kq = tid >> 7;
    f32x4 vv[8];
#pragma unroll
    for (int s = 0; s < 8; ++s) { const u32x2 g = *(const u32x2*)(VG + (size_t)(m0 + s) * 2048 + h * 512 + 4 * v4); vv[s] = (f32x4){bflo(g.x), bfhi(g.x), bflo(g.y), bfhi(g.y)}; }
    f32x4 acc[8];
#pragma unroll
    for (int t = 0; t < 8; ++t) acc[t] = (f32x4){0.f, 0.f, 0.f, 0.f};
    { const f32x4* S0 = (const f32x4*)(C.in[2] + ((size_t)(b * 4 + h) * 256 + kq * 64) * 512) + v4;
      f32x4* SN = (f32x4*)(C.out + O_SS + ((size_t)(b * 4 + h) * 256 + kq * 64) * 512) + v4;
#pragma unroll 4
      for (int kk = 0; kk < 64; ++kk) { const int k = kq * 64 + kk; const f32x4 s4 = S0[(size_t)kk * 128];
          const f32x4 a0 = *(const LAS f32x4*)(sAq + k * 8), a1 = *(const LAS f32x4*)(sAq + k * 8 + 4);
          const f32x4 k0 = *(const LAS f32x4*)(sKd + k * 8), k1 = *(const LAS f32x4*)(sKd + k * 8 + 4); const float dc = sDec[k];
          acc[0] += s4 * a0.x; acc[1] += s4 * a0.y; acc[2] += s4 * a0.z; acc[3] += s4 * a0.w; acc[4] += s4 * a1.x; acc[5] += s4 * a1.y; acc[6] += s4 * a1.z; acc[7] += s4 * a1.w;
          f32x4 sn = s4 * dc; sn += vv[0] * k0.x; sn += vv[1] * k0.y; sn += vv[2] * k0.z; sn += vv[3] * k0.w; sn += vv[4] * k1.x; sn += vv[5] * k1.y; sn += vv[6] * k1.z; sn += vv[7] * k1.w;
          SN[(size_t)kk * 128] = sn; } }
#pragma unroll
    for (int t = 0; t < 8; ++t) *(LAS f32x4*)(red + (size_t)((kq * 8 + t) * 512) + 4 * v4) = acc[t];
    __syncthreads();
    f32x4 o2[2];
#pragma unroll
    for (int e = 0; e < 2; ++e) { const int t = 2 * kq + e; f32x4 o = {0.f, 0.f, 0.f, 0.f};
#pragma unroll
        for (int q = 0; q < 4; ++q) o += *(const LAS f32x4*)(red + (size_t)((q * 8 + t) * 512) + 4 * v4);
#pragma unroll
        for (int s = 0; s < 8; ++s) o += vv[s] * sSc[t * 8 + s];
        o2[e] = o; float ss = (o.x * o.x + o.y * o.y) + (o.z * o.z + o.w * o.w); ss = wave_sum(ss);
        if (lane == 0) sSs[t * 2 + (w & 1)] = ss; }
    __syncthreads();
    const f32x4 n4 = *(const f32x4*)(C.in[13] + 4 * v4);
#pragma unroll
    for (int e = 0; e < 2; ++e) { const int t = 2 * kq + e; const float rs = 1.f / sqrtf((sSs[t * 2] + sSs[t * 2 + 1]) * (1.f / 512.f) + RMS_EPS);
        const size_t off = (size_t)(m0 + t) * 2048 + h * 512 + 4 * v4; const u32x2 g = *(const u32x2*)(GG + off);
        u32x2 o; o.x = pk2(o2[e].x * rs * n4.x * bflo(g.x), o2[e].y * rs * n4.y * bfhi(g.x)); o.y = pk2(o2[e].z * rs * n4.z * bflo(g.y), o2[e].w * rs * n4.w * bfhi(g.y));
        *(u32x2*)(OG + off) = o; }
    __syncthreads();
}
DI void dswa_item(const Ctx& C, int item) {
    const int b = item >> 3, kvh = item & 7, tid = C.tid, m0 = MP + 8 * b;
    LAS float* sK = (LAS float*)(C.lds);
    LAS float* sV = (LAS float*)(C.lds + 36992);
    LAS float* sQ = (LAS float*)(C.lds + 73984);
    LAS float* sP = (LAS float*)(C.lds + 82176);
    const bf16* QS = WSP(bf16, WS_QS); const bf16* KS = WSP(bf16, WS_KS); const bf16* VS = WSP(bf16, WS_VS); bf16* OS = WSP(bf16, WS_OS);
    for (int idx = tid; idx < 128 * 16; idx += NTHR) { const int row = idx >> 4, c4 = idx & 15;
        const size_t so = ((size_t)(b * 128 + row) * 8 + kvh) * 64 + 4 * c4;
        const f32x4 kv = *(const f32x4*)(C.in[3] + so), vv = *(const f32x4*)(C.in[4] + so);
        *(LAS f32x4*)(sK + row * 68 + 4 * c4) = kv; *(LAS f32x4*)(sV + row * 68 + 4 * c4) = vv;
        if (row >= 8) { const size_t oo = ((size_t)(b * 128 + row - 8) * 8 + kvh) * 64 + 4 * c4; *(f32x4*)(C.out + O_KS + oo) = kv; *(f32x4*)(C.out + O_VS + oo) = vv; } }
    if (tid < 128) { const int t = tid >> 4, c4 = tid & 15; const size_t so = (size_t)(m0 + t) * 512 + kvh * 64 + 4 * c4;
        const u32x2 kq = *(const u32x2*)(KS + so), vq = *(const u32x2*)(VS + so);
        *(LAS f32x4*)(sK + (128 + t) * 68 + 4 * c4) = (f32x4){bflo(kq.x), bfhi(kq.x), bflo(kq.y), bfhi(kq.y)};
        *(LAS f32x4*)(sV + (128 + t) * 68 + 4 * c4) = (f32x4){bflo(vq.x), bfhi(vq.x), bflo(vq.y), bfhi(vq.y)}; }
    { const int row = tid >> 4, c4 = tid & 15, g = row >> 3, t = row & 7;
      const u32x2 q = *(const u32x2*)(QS + (size_t)(m0 + t) * 2048 + (kvh * 4 + g) * 64 + 4 * c4);
      *(LAS f32x4*)(sQ + row * 64 + 4 * c4) = (f32x4){bflo(q.x), bfhi(q.x), bflo(q.y), bfhi(q.y)}; }
    __syncthreads();
    { const int row = tid >> 4, jl = tid & 15, g = row >> 3, t = row & 7, hq = kvh * 4 + g;
      const float slope = exp2f(-0.25f * (float)(hq + 1)), sink = C.in[14][hq];
      float sc[9]; float mx = -3.0e38f;
#pragma unroll
      for (int i = 0; i < 9; ++i) sc[i] = 0.f;
#pragma unroll 2
      for (int c4 = 0; c4 < 16; ++c4) { const f32x4 q = *(const LAS f32x4*)(sQ + row * 64 + 4 * c4);
#pragma unroll
          for (int i = 0; i < 9; ++i) { int j = jl + 16 * i; j = j < 136 ? j : 135; const f32x4 kx = *(const LAS f32x4*)(sK + j * 68 + 4 * c4); sc[i] += (q.x * kx.x + q.y * kx.y) + (q.z * kx.z + q.w * kx.w); } }
#pragma unroll
      for (int i = 0; i < 9; ++i) { const int j = jl + 16 * i; const int dist = 128 + t - j; float s = -3.0e38f;
          if (j < 136 && dist >= 0 && dist < 128) s = sc[i] - slope * (float)dist;
          sc[i] = s; mx = fmaxf(mx, s); }
#pragma unroll
      for (int o = 1; o < 16; o <<= 1) mx = fmaxf(mx, __shfl_xor(mx, o));
      mx = fmaxf(mx, sink); float sum = 0.f;
#pragma unroll
      for (int i = 0; i < 9; ++i) { const float e = (sc[i] > -1.0e38f) ? __expf(sc[i] - mx) : 0.f; sc[i] = e; sum += e; }
#pragma unroll
      for (int o = 1; o < 16; o <<= 1) sum += __shfl_xor(sum, o);
      const float inv = 1.f / (sum + __expf(sink - mx));
#pragma unroll
      for (int i = 0; i < 9; ++i) { const int j = jl + 16 * i; if (j < 136) sP[row * 136 + j] = sc[i] * inv; } }
    __syncthreads();
    { const int row = tid >> 4, dq = tid & 15, g = row >> 3, t = row & 7; f32x4 o = {0.f, 0.f, 0.f, 0.f};
      for (int j = 0; j < 136; ++j) { const float p = sP[row * 136 + j]; o += *(const LAS f32x4*)(sV + j * 68 + 4 * dq) * p; }
      u32x2 w; w.x = pk2(o.x, o.y); w.y = pk2(o.z, o.w);
      *(u32x2*)(OS + (size_t)(m0 + t) * 2048 + (kvh * 4 + g) * 64 + 4 * dq) = w; }
    __syncthreads();
}
DI void pswa_item(const Ctx& C, int item) {
    const int n = item >> 3, kvh = item & 7, w = C.wave, r = C.lane & 31, hh = C.lane >> 5, g = w >> 1, th = w & 1, hq = kvh * 4 + g;
    const bf16* QS = WSP(bf16, WS_QS); const bf16* KS = WSP(bf16, WS_KS); const bf16* VST = WSP(bf16, WS_VST); bf16* OS = WSP(bf16, WS_OS);
    const float slope = exp2f(-0.25f * (float)(hq + 1)), sink = C.in[14][hq];
#pragma unroll 1
    for (int pass = 0; pass < 2; ++pass) {
        const int i0 = 64 * th + 32 * pass, qtok = 128 * n + i0 + r;
        bf16x8 qf[4];
#pragma unroll
        for (int ks = 0; ks < 4; ++ks) qf[ks] = *(const bf16x8*)(QS + (size_t)qtok * 2048 + hq * 64 + 16 * ks + 8 * hh);
        f32x16 s[5];
#pragma unroll
        for (int jj = 0; jj < 5; ++jj) {
#pragma unroll
            for (int e = 0; e < 16; ++e) s[jj][e] = 0.f;
            int kt = (n - 1) * 128 + i0 + 32 * jj + r; kt = kt < 0 ? 0 : kt;
#pragma unroll
            for (int ks = 0; ks < 4; ++ks) { const bf16x8 kf = *(const bf16x8*)(KS + (size_t)kt * 512 + kvh * 64 + 16 * ks + 8 * hh); s[jj] = MFMA32(kf, qf[ks], s[jj]); }
            asm volatile("" ::: "memory"); }
        float mx = -3.0e38f;
        int rr = r - 4 * hh; asm volatile("" : "+v"(rr));
#pragma unroll
        for (int jj = 0; jj < 5; ++jj)
#pragma unroll
            for (int e = 0; e < 16; ++e) { const int cr0 = (e & 3) + 8 * (e >> 2); const int dist = 128 + rr - 32 * jj - cr0; const int j = i0 + 32 * jj + cr0 + 4 * hh;
                const bool valid = (dist >= 0) && (dist < 128) && (n > 0 || j >= 128);
                const float v = valid ? s[jj][e] - slope * (float)dist : -3.0e38f; s[jj][e] = v; mx = fmaxf(mx, v); }
        mx = fmaxf(mx, __shfl_xor(mx, 32)); mx = fmaxf(mx, sink);
        float sum = 0.f;
#pragma unroll
        for (int jj = 0; jj < 5; ++jj)
#pragma unroll
            for (int e = 0; e < 16; ++e) { const float p = (s[jj][e] > -1.0e38f) ? __expf(s[jj][e] - mx) : 0.f; s[jj][e] = p; sum += p; }
        sum += __shfl_xor(sum, 32);
        const float inv = 1.f / (sum + __expf(sink - mx));
        f32x16 o[2];
#pragma unroll
        for (int md = 0; md < 2; ++md)
#pragma unroll
            for (int e = 0; e < 16; ++e) o[md][e] = 0.f;
#pragma unroll
        for (int jj = 0; jj < 5; ++jj) {
            int kb = (n - 1) * 128 + i0 + 32 * jj; kb = kb < 0 ? 0 : kb;
#pragma unroll
            for (int st = 0; st < 2; ++st) {
                u32x4 pw; pw.x = pk2(s[jj][8 * st], s[jj][8 * st + 1]); pw.y = pk2(s[jj][8 * st + 2], s[jj][8 * st + 3]); pw.z = pk2(s[jj][8 * st + 4], s[jj][8 * st + 5]); pw.w = pk2(s[jj][8 * st + 6], s[jj][8 * st + 7]);
                const bf16x8 pb = __builtin_bit_cast(bf16x8, pw);
#pragma unroll
                for (int md = 0; md < 2; ++md) { const bf16* vp = VST + (size_t)(kvh * 64 + 32 * md + r) * 8192 + kb + 16 * st + 4 * hh;
                    const u32x2 lo = *(const u32x2*)vp, hi = *(const u32x2*)(vp + 8); u32x4 aw; aw.x = lo.x; aw.y = lo.y; aw.z = hi.x; aw.w = hi.y;
                    o[md] = MFMA32(__builtin_bit_cast(bf16x8, aw), pb, o[md]); } }
            asm volatile("" ::: "memory"); }
#pragma unroll
        for (int md = 0; md < 2; ++md)
#pragma unroll
            for (int q = 0; q < 4; ++q) { u32x2 ow; ow.x = pk2(o[md][4 * q] * inv, o[md][4 * q + 1] * inv); ow.y = pk2(o[md][4 * q + 2] * inv, o[md][4 * q + 3] * inv);
                *(u32x2*)(OS + (size_t)qtok * 2048 + hq * 64 + 32 * md + 8 * q + 4 * hh) = ow; }
    }
}

constexpr int CW_BAR = 4096;
#define XB_TMO      128
#define XB_XCNT(j)  (256  + 64 * (j))
#define XB_XSUB(j)  (1280 + 64 * (j))
#define XB_XGEN(j)  (2304 + 64 * (j))
#define XB_TOP      3328
#define XB_TOPGEN   3392
#define XCD_BAR_WORDS 3456
#define XB_SPIN_CAP (1u << 18)

__device__ __forceinline__ unsigned xb_ld(unsigned* p)              { return __hip_atomic_load(p, __ATOMIC_RELAXED, __HIP_MEMORY_SCOPE_AGENT); }
__device__ __forceinline__ unsigned xb_add(unsigned* p, unsigned v) { return __hip_atomic_fetch_add(p, v, __ATOMIC_RELAXED, __HIP_MEMORY_SCOPE_AGENT); }
__device__ __forceinline__ unsigned xb_xcc_id() { return (unsigned)__builtin_amdgcn_s_getreg((3 << 11) | 20) & 0xFu; }
#define XB_SPIN(cond, bar) do { unsigned _sp = 0; while (cond) { __builtin_amdgcn_s_sleep(1); \
    if ((++_sp & 255u) == 0u) { if (xb_ld(&(bar)[XB_TMO])) break; if (_sp > XB_SPIN_CAP) { atomicAdd(&(bar)[XB_TMO], 1u); break; } } } } while (0)

struct XcdBarrier {
    unsigned* bar; unsigned x;
    volatile LAS unsigned* st;
};

__device__ __forceinline__ XcdBarrier xcd_barrier_post(unsigned* bar, volatile LAS unsigned* st) {
    XcdBarrier b; b.bar = bar; b.x = xb_xcc_id(); b.st = st;
    if (threadIdx.x == 0) (void)xb_add(&bar[XB_XCNT(b.x)], 1u);
    return b;
}
__device__ __forceinline__ void xcd_barrier_complete(unsigned* bar, unsigned x, unsigned& nloc, unsigned& nx) {
    const unsigned G = gridDim.x * gridDim.y * gridDim.z;
    unsigned sum, cnt, mine, sp = 0u;
    for (;;) {
        sum = 0u; cnt = 0u; mine = 0u;
#pragma unroll
        for (unsigned j = 0; j < 16; ++j) { const unsigned c = xb_ld(&bar[XB_XCNT(j)]); sum += c; cnt += (c > 0u) ? 1u : 0u; mine = (j == x) ? c : mine; }
        if (sum == G) break;
        __builtin_amdgcn_s_sleep(1);
        if ((++sp & 255u) == 0u) { if (xb_ld(&bar[XB_TMO])) break; if (sp > XB_SPIN_CAP) { atomicAdd(&bar[XB_TMO], 1u); break; } }
    }
    nloc = mine > 0u ? mine : 1u; nx = cnt > 0u ? cnt : 1u;
}

__device__ __forceinline__ void xcd_barrier(const XcdBarrier& b) {
    asm volatile("s_waitcnt vmcnt(0)" ::: "memory");
    __syncthreads();
    if (threadIdx.x == 0) {
        unsigned* bar = b.bar;
        __builtin_amdgcn_s_waitcnt(0);
        unsigned nloc = b.st[0], nx = b.st[1];
        if (nloc == 0u) { xcd_barrier_complete(bar, b.x, nloc, nx); b.st[0] = nloc; b.st[1] = nx; }
        const unsigned old = xb_add(&bar[XB_XSUB(b.x)], 1u);
        const unsigned gen = old / nloc;
        if (old + 1u == (gen + 1u) * nloc) {
            __builtin_amdgcn_fence(__ATOMIC_RELEASE, "agent");
            asm volatile("s_waitcnt vmcnt(0)" ::: "memory");
            const unsigned og = xb_add(&bar[XB_TOP], 1u);
            const unsigned tg = og / nx;
            if (og + 1u == (tg + 1u) * nx) xb_add(&bar[XB_TOPGEN], 1u);
            else XB_SPIN(xb_ld(&bar[XB_TOPGEN]) == tg, bar);
            __builtin_amdgcn_fence(__ATOMIC_ACQUIRE, "agent");
            xb_add(&bar[XB_XGEN(b.x)], 1u);
            asm volatile("s_waitcnt vmcnt(0)" ::: "memory");
        } else {
            XB_SPIN(xb_ld(&bar[XB_XGEN(b.x)]) == gen, bar);
            __builtin_amdgcn_fence(__ATOMIC_ACQUIRE, "agent");
            asm volatile("s_waitcnt vmcnt(0)" ::: "memory");
        }
    }
    __syncthreads();
}

#ifndef MK_N_LAUNCHES
#define MK_N_LAUNCHES 1
#endif
constexpr int N_PHASES = 15;
__global__ void __launch_bounds__(NTHR, 2) hybrid_fwd(Args args) {
    extern __shared__ __attribute__((aligned(16))) unsigned char lds_raw[];
    Ctx C;
    C.lds = (LAS unsigned char*)lds_raw; C.tid = threadIdx.x; C.lane = C.tid & 63; C.wave = __builtin_amdgcn_readfirstlane(C.tid >> 6);
    C.G = gridDim.x; C.bid = blockIdx.x; C.in = args.in; C.out = args.out; C.ws = args.ws;
    const int lo = args.ph_lo, hi = args.ph_hi;
    unsigned* ctl = (unsigned*)(args.ws + WS_CTL);
    volatile LAS unsigned* misc = (volatile LAS unsigned*)(C.lds + LDS_MISC);
#ifndef USE_CG_SYNC
    if (C.tid < 16) misc[C.tid] = 0u;
    __syncthreads();
    XcdBarrier bar = xcd_barrier_post(ctl + CW_BAR, misc + 8);
#define GRID_SYNC() xcd_barrier(bar)
#else
#define GRID_SYNC() cg::this_grid().sync()
#endif
#ifndef PH_MASK
#define PH_MASK 0xFFFFFFFFu
#endif
#define IN(k) ((((PH_MASK) >> (k)) & 1u) && lo <= (k) && (k) < hi)
#define OPAQUE_CTX() Ctx C2 = C; asm volatile("" : "+v"(C2.tid), "+v"(C2.lane))
#define SEAM(k) do { if (IN(k) && IN((k) + 1)) { GRID_SYNC(); } } while (0)
    typedef pg8::bf16_t pb;
    if (IN(0)) { p0_prologue(C); }
    SEAM(0);
    if (IN(1)) { pg8::Gemm g{WSP(pb, WS_XB), WSP(pb, WS_WF1), MT, 2 * DFF, DM}; pg8::StaticOrder S; S.init(MT, 2 * DFF, C.G, C.bid);
        pg8::EpiSwiglu E{WSP(pb, WS_HB), DFF}; pg8::gemm_phase<pg8::EpiSwiglu, pg8::StaticOrder, true, true>(C.lds, g, S, E); }
    SEAM(1);
    if (IN(2)) { pg8::Gemm g{WSP(pb, WS_HB), WSP(pb, WS_WF2), MT, DM, DFF}; pg8::StaticOrder S; S.init(MT, DM, C.G, C.bid);
        pg8::EpiRes E{C.in[0], C.in[1], WSP(float, WS_Y), ALPHA, 0.5f}; pg8::gemm_phase<pg8::EpiRes, pg8::StaticOrder, true, true>(C.lds, g, S, E); }
    SEAM(2);
    if (IN(3)) { ln_phase(C, WSP(float, WS_Y), C.in[7], C.in[8], WSP(float, WS_X), WSP(bf16, WS_XB)); }
    SEAM(3);
    if (IN(4)) { pg8::Gemm g{WSP(pb, WS_XB), WSP(pb, WS_WIN), MT, DINP, DM}; pg8::StaticOrder S; S.init(MT, DINP, C.G, C.bid);
        pg8::EpiZ E{WSP(pb, WS_QG), WSP(pb, WS_KG), WSP(pb, WS_VG), WSP(pb, WS_GG), WSP(pb, WS_QS), WSP(pb, WS_KS), WSP(pb, WS_VS), WSP(pb, WS_SGG), WSP(pb, WS_SGS), WSP(float, WS_RG), WSP(float, WS_BP), C.out};
        pg8::gemm_phase<pg8::EpiZ, pg8::StaticOrder, true, true>(C.lds, g, S, E); }
    SEAM(4);
    if (IN(5)) {
        for (int it = C.bid; it < NCH * 4; it += C.G) { OPAQUE_CTX(); g1_item(C2, it); }
        for (int it = C.bid; it < 128 * 8; it += C.G) { OPAQUE_CTX(); dswa_item(C2, it); }
        { LAS unsigned short* scr = (LAS unsigned short*)(C.lds + C.wave * 8192); const int gw = C.bid * NWAVES + C.wave, NGW = C.G * NWAVES;
          for (int it = gw; it < 128 * 64 + 128 * 16; it += NGW) {
              if (it < 128 * 64) tr_item(WSP(bf16, WS_VG), 2048, WSP(bf16, WS_VT), it, scr, C.lane);
              else tr_item(WSP(bf16, WS_VS), 512, WSP(bf16, WS_VST), it - 128 * 64, scr, C.lane); } }
    }
    SEAM(5);
    if (IN(6)) {
        if (C.bid < 64) { OPAQUE_CTX(); g2_item(C2, C.bid); }
        for (;;) {
            if (C.tid == 0) misc[0] = __hip_atomic_fetch_add(ctl + CW_QUEUE, 1u, __ATOMIC_RELAXED, __HIP_MEMORY_SCOPE_AGENT);
            __syncthreads();
            const int it = (int)misc[0];
            __syncthreads();
            if (it >= 1024) break;
            OPAQUE_CTX();
            if (it < 512) dgla_item(C2, it); else pswa_item(C2, it - 512);
        }
    }
    SEAM(6);
    if (IN(7)) { for (int it = C.bid; it < NCH * 4; it += C.G) { OPAQUE_CTX(); g3_item(C2, it); } }
    SEAM(7);
    if (IN(8)) { pg8::Gemm g{WSP(pb, WS_OG), WSP(pb, WS_WBG), MT, DM, DM}; pg8::StaticOrder S; S.init(MT, DM, C.G, C.bid);
        pg8::EpiGateMul E{WSP(pb, WS_SGG), WSP(float, WS_Y)}; pg8::gemm_phase<pg8::EpiGateMul, pg8::StaticOrder, true, true>(C.lds, g, S, E); }
    SEAM(8);
    if (IN(9)) { pg8::Gemm g{WSP(pb, WS_OS), WSP(pb, WS_WBS), MT, DM, DM}; pg8::StaticOrder S; S.init(MT, DM, C.G, C.bid);
        pg8::EpiMerge E{WSP(pb, WS_SGS), WSP(float, WS_Y), WSP(pb, WS_MG)}; pg8::gemm_phase<pg8::EpiMerge, pg8::StaticOrder, true, true>(C.lds, g, S, E); }
    SEAM(9);
    if (IN(10)) { pg8::Gemm g{WSP(pb, WS_MG), WSP(pb, WS_WO), MT, DM, DM}; pg8::StaticOrder S; S.init(MT, DM, C.G, C.bid);
        pg8::EpiRes E{WSP(float, WS_X), WSP(float, WS_X) + (size_t)MP * DM, WSP(float, WS_Y), ALPHA, 1.0f}; pg8::gemm_phase<pg8::EpiRes, pg8::StaticOrder, true, true>(C.lds, g, S, E); }
    SEAM(10);
    if (IN(11)) { ln_phase(C, WSP(float, WS_Y), C.in[18], C.in[19], WSP(float, WS_X), WSP(bf16, WS_XB)); conv_ffn(C, C.in[20], C.in[21]); }
    SEAM(11);
    if (IN(12)) { pg8::Gemm g{WSP(pb, WS_XB), WSP(pb, WS_WF1), MT, 2 * DFF, DM}; pg8::StaticOrder S; S.init(MT, 2 * DFF, C.G, C.bid);
        pg8::EpiSwiglu E{WSP(pb, WS_HB), DFF}; pg8::gemm_phase<pg8::EpiSwiglu, pg8::StaticOrder, true, true>(C.lds, g, S, E); }
    SEAM(12);
    if (IN(13)) { pg8::Gemm g{WSP(pb, WS_HB), WSP(pb, WS_WF2), MT, DM, DFF}; pg8::StaticOrder S; S.init(MT, DM, C.G, C.bid);
        pg8::EpiRes E{WSP(float, WS_X), WSP(float, WS_X) + (size_t)MP * DM, WSP(float, WS_Y), ALPHA, 0.5f}; pg8::gemm_phase<pg8::EpiRes, pg8::StaticOrder, true, true>(C.lds, g, S, E); }
    SEAM(13);
    if (IN(14)) { ln_phase(C, WSP(float, WS_Y), C.in[22], C.in[23], C.out + O_YP, nullptr); }
#undef IN
#undef SEAM
}


#ifdef DEBUG_PROBE
constexpr int CW_CHK = 1024;
constexpr int N_STAGES = 19;
DI unsigned hash32(unsigned x) { x ^= x >> 16; x *= 0x7feb352dU; x ^= x >> 15; x *= 0x846ca68bU; x ^= x >> 16; return x; }
DI float dsilu(float x) { return x / (1.f + expf(-x)); }
DI float dsigm(float x) { return 1.f / (1.f + expf(-x)); }
DI int seg_start(int i) { switch (i) { case 0: return 0; case 1: return 1024; case 2: return 2048; case 3: return 4096; case 4: return 6144; case 5: return 6160; case 6: return 8208; case 7: return 8720; case 8: return 9232; case 9: return 11280; default: return 13328; } }
DI float dot_bw(const bf16* a, const float* W, int ldw, int col, int K) { float s = 0.f; for (int k = 0; k < K; ++k) s += bf2f(a[k]) * W[(size_t)k * ldw + col]; return s; }
#define WSQ(T, off) ((T*)(ws + (off)))
#define CMP(got, ref) do { const float g_ = (got), r_ = (ref); e2 += (g_ - r_) * (g_ - r_); r2 += r_ * r_; } while (0)
__global__ void __launch_bounds__(256) chk_kernel(Args args, int stage) {
    unsigned char* ws = args.ws; float* slot = (float*)(ws + WS_CTL) + CW_CHK + 2 * stage; float* out = args.out;
    const int tid = threadIdx.x, gid = blockIdx.x * 256 + tid;
    const unsigned h1 = hash32(gid * 2654435761u + stage * 977u + 12345u), h2 = hash32(h1 + 0x9e3779b9u), h3 = hash32(h2 + 0x85ebca6bu);
    float e2 = 0.f, r2 = 0.f;
    __shared__ float sh[8 * 256 * 3 + 64];
    if (stage == 1 || stage == 16) {
        const float* wi = args.in[stage == 1 ? 5 : 20]; const float* wo = args.in[stage == 1 ? 6 : 21];
        { const int n = h1 % 11264, k = h2 % 2048, pn = n >> 8, wq = n & 255, src = wq < 128 ? 128 * pn + wq : DFF + 128 * pn + wq - 128;
          CMP(bf2f(WSQ(bf16, WS_WF1)[(size_t)n * 2048 + k]), wi[(size_t)k * 11264 + src]); }
        { const int n = h2 % 2048, k = h3 % 5632; CMP(bf2f(WSQ(bf16, WS_WF2)[(size_t)n * 5632 + k]), wo[(size_t)k * 2048 + n]); }
        if (stage == 1) {
            { const int n = h3 % DINP, k = h1 % 2048; float ref = 0.f; if (n < 6144) ref = args.in[9][(size_t)k * DIN + n]; else if (n < 13312) ref = args.in[9][(size_t)k * DIN + n + 16]; else if (n < 13328) ref = args.in[9][(size_t)k * DIN + n - 13312 + 6144];
              CMP(bf2f(WSQ(bf16, WS_WIN)[(size_t)n * 2048 + k]), ref); }
            { const int n = h1 % 2048, k = h3 % 2048; CMP(bf2f(WSQ(bf16, WS_WBG)[(size_t)n * 2048 + k]), args.in[15][(size_t)k * 2048 + n]);
              CMP(bf2f(WSQ(bf16, WS_WBS)[(size_t)n * 2048 + k]), args.in[16][(size_t)k * 2048 + n]); CMP(bf2f(WSQ(bf16, WS_WO)[(size_t)n * 2048 + k]), args.in[17][(size_t)k * 2048 + n]); }
            { const int m = h2 % MT, k = h1 % 2048; const float xr = m < MP ? args.in[0][(size_t)m * DM + k] : args.in[1][(size_t)(m - MP) * DM + k]; CMP(bf2f(WSQ(bf16, WS_XB)[(size_t)m * DM + k]), xr); }
            { const int i = h3 % DINP; float ref = 0.f; if (i < 6144) ref = args.in[10][i]; else if (i < 13312) ref = args.in[10][i + 16]; else if (i < 13328) ref = args.in[10][i - 13312 + 6144]; CMP(WSQ(float, WS_BP)[i], ref); }
        }
    }
    if (stage == 2 || stage == 17) {
        const float* wi = args.in[stage == 2 ? 5 : 20]; const int m = h1 % MT, j = h2 % DFF; const bf16* a = WSQ(bf16, WS_XB) + (size_t)m * DM;
        const float g = dot_bw(a, wi, 2 * DFF, j, DM), u = dot_bw(a, wi, 2 * DFF, DFF + j, DM);
        CMP(bf2f(WSQ(bf16, WS_HB)[(size_t)m * DFF + j]), dsilu(g) * u);
    }
    if (stage == 3 || stage == 18) {
        const float* wo = args.in[stage == 3 ? 6 : 21]; const int m = h1 % MT, n = h2 % DM;
        const float xr = stage == 3 ? (m < MP ? args.in[0][(size_t)m * DM + n] : args.in[1][(size_t)(m - MP) * DM + n]) : WSQ(float, WS_X)[(size_t)m * DM + n];
        CMP(WSQ(float, WS_Y)[(size_t)m * DM + n], ALPHA * xr + 0.5f * dot_bw(WSQ(bf16, WS_HB) + (size_t)m * DFF, wo, DM, n, DFF));
    }
    if (stage == 4 || stage == 16 || stage == 19) {
        const float* lw = args.in[stage == 4 ? 7 : (stage == 16 ? 18 : 22)]; const float* lb = args.in[stage == 4 ? 8 : (stage == 16 ? 19 : 23)];
        const int m = h1 % MT; const float* y = WSQ(float, WS_Y) + (size_t)m * DM; float s = 0.f;
        for (int k = 0; k < DM; ++k) s += y[k];
        const float mean = s / DM; float q = 0.f;
        for (int k = 0; k < DM; ++k) q += (y[k] - mean) * (y[k] - mean);
        const float rstd = 1.f / sqrtf(q / DM + LN_EPS);
        for (int i = 0; i < 8; ++i) { const int n = hash32(h2 + i) % DM; const float ref = (y[n] - mean) * rstd * lw[n] + lb[n];
            if (stage == 19) CMP(out[O_YP + (size_t)m * DM + n], ref);
            else { CMP(WSQ(float, WS_X)[(size_t)m * DM + n], ref); CMP(bf2f(WSQ(bf16, WS_XB)[(size_t)m * DM + n]), ref); } }
    }
    if (stage == 5) {
        const int seg = gid % 10; const int sg0 = seg_start(seg), sg1 = seg_start(seg + 1);
        int m = h1 % MT; if ((seg == 6 || seg == 7) && (h3 & 1)) m = 8064 + h1 % (MT - 8064);
        const int n = sg0 + h2 % (sg1 - sg0), c = n - sg0;
        const float d = dot_bw(WSQ(bf16, WS_XB) + (size_t)m * DM, args.in[9], DIN, n, DM) + args.in[10][n];
        if (seg == 0) CMP(bf2f(WSQ(bf16, WS_QG)[(size_t)m * 1024 + c]), d * 0.0625f);
        if (seg == 1) CMP(bf2f(WSQ(bf16, WS_KG)[(size_t)m * 1024 + c]), d);
        if (seg == 2) CMP(bf2f(WSQ(bf16, WS_VG)[(size_t)m * 2048 + c]), d);
        if (seg == 3) CMP(bf2f(WSQ(bf16, WS_GG)[(size_t)m * 2048 + c]), dsilu(d));
        if (seg == 4) CMP(WSQ(float, WS_RG)[(size_t)m * 16 + c], d);
        if (seg == 5) CMP(bf2f(WSQ(bf16, WS_QS)[(size_t)m * 2048 + c]), d * 0.125f);
        if (seg == 6 || seg == 7) { CMP(bf2f(WSQ(bf16, seg == 6 ? WS_KS : WS_VS)[(size_t)m * 512 + c]), d);
            if (m >= MP) { const int rr = m - MP; CMP(out[(seg == 6 ? O_KS : O_VS) + ((size_t)((rr >> 3) * 128 + 120 + (rr & 7))) * 512 + c], d); }
            else if (m >= 8064) CMP(out[(seg == 6 ? O_KP : O_VP) + (size_t)(m - 8064) * 512 + c], d); }
        if (seg == 8) CMP(bf2f(WSQ(bf16, WS_SGG)[(size_t)m * 2048 + c]), dsigm(d));
        if (seg == 9) CMP(bf2f(WSQ(bf16, WS_SGS)[(size_t)m * 2048 + c]), dsigm(d));
    }
    const float* RG = WSQ(float, WS_RG); const float* wgg = args.in[11]; const float* bgg = args.in[12];
    if (stage == 6) {
        const int c = h1 % NCH, h = h2 & 3, tl = (h2 >> 2) & 63, k = (h2 >> 8) & 255, t0 = 64 * c; float run = 0.f, bt = 0.f;
        for (int tau = 0; tau < 64; ++tau) { float x = bgg[h * 256 + k]; for (int r = 0; r < 16; ++r) x += RG[(size_t)(t0 + tau) * 16 + r] * wgg[r * 1024 + h * 256 + k]; run += logsig16(x); if (tau == tl) bt = run; }
        const float q = bf2f(WSQ(bf16, WS_QG)[(size_t)(t0 + tl) * 1024 + h * 256 + k]), kk = bf2f(WSQ(bf16, WS_KG)[(size_t)(t0 + tl) * 1024 + h * 256 + k]);
        CMP(bf2f(WSQ(bf16, WS_AQ)[((size_t)(c * 4 + h) * 64 + tl) * 256 + k]), q * expf(bt));
        CMP(bf2f(WSQ(bf16, WS_KDT)[((size_t)(c * 4 + h) * 256 + k) * 64 + tl]), kk * expf(run - bt));
        CMP(WSQ(float, WS_DEC)[(c * 4 + h) * 256 + k], expf(run));
        if (gid < 128) { const int s = (h3 >> 3) & 63; float p = 0.f;
            for (int k2 = 0; k2 < 256; ++k2) { float rn = 0.f, b_t = 0.f, b_s = 0.f;
                for (int tau = 0; tau < 64; ++tau) { float x = bgg[h * 256 + k2]; for (int r = 0; r < 16; ++r) x += RG[(size_t)(t0 + tau) * 16 + r] * wgg[r * 1024 + h * 256 + k2]; rn += logsig16(x); if (tau == tl) b_t = rn; if (tau == s) b_s = rn; }
                p += bf2f(WSQ(bf16, WS_QG)[(size_t)(t0 + tl) * 1024 + h * 256 + k2]) * bf2f(WSQ(bf16, WS_KG)[(size_t)(t0 + s) * 1024 + h * 256 + k2]) * expf(b_t - b_s); }
            CMP(bf2f(WSQ(bf16, WS_PP)[((size_t)(c * 4 + h) * 64 + tl) * 64 + s]), s <= tl ? p : 0.f); }
    }
    if (stage == 7) {
        { const int c = h1 % 2048, t = h2 % 8192; CMP(bf2f(WSQ(bf16, WS_VT)[(size_t)c * 8192 + t]), bf2f(WSQ(bf16, WS_VG)[(size_t)t * 2048 + c])); }
        { const int c = h3 % 512, t = h1 % 8192; CMP(bf2f(WSQ(bf16, WS_VST)[(size_t)c * 8192 + t]), bf2f(WSQ(bf16, WS_VS)[(size_t)t * 512 + c])); }
    }
    if (stage == 8 || stage == 11) {
        const int hq = h2 & 31, kvh = hq >> 2; const float slope = exp2f(-0.25f * (float)(hq + 1)), sink = args.in[14][hq];
        int qrow, nkeys; const int b = h1 % 128, t = (h1 >> 8) & 7, tok = h1 % MP;
        if (stage == 8) { qrow = MP + 8 * b + t; nkeys = 136; } else { qrow = tok; nkeys = 128; }
        float mx = sink, den = 0.f; float o[10];
#pragma unroll
        for (int i = 0; i < 10; ++i) o[i] = 0.f;
        for (int pass = 0; pass < 2; ++pass) {
            for (int j = 0; j < nkeys; ++j) { float d = 0.f; bool valid; int dist; int kt = 0;
                if (stage == 8) { dist = 128 + t - j; valid = dist >= 0 && dist < 128;
                    for (int e = 0; e < 64; ++e) { const float kx = j < 128 ? args.in[3][((size_t)(b * 128 + j) * 8 + kvh) * 64 + e] : bf2f(WSQ(bf16, WS_KS)[(size_t)(MP + 8 * b + j - 128) * 512 + kvh * 64 + e]);
                        d += bf2f(WSQ(bf16, WS_QS)[(size_t)qrow * 2048 + hq * 64 + e]) * kx; } }
                else { kt = tok - 127 + j; dist = tok - kt; valid = kt >= 0;
                    if (valid) for (int e = 0; e < 64; ++e) d += bf2f(WSQ(bf16, WS_QS)[(size_t)qrow * 2048 + hq * 64 + e]) * bf2f(WSQ(bf16, WS_KS)[(size_t)kt * 512 + kvh * 64 + e]); }
                const float sj = d - slope * (float)dist;
                if (pass == 0) { if (valid) mx = fmaxf(mx, sj); }
                else if (valid) { const float p = expf(sj - mx); den += p;
#pragma unroll
                    for (int i = 0; i < 10; ++i) { const int e = 7 * i; float vx;
                        if (stage == 8) vx = j < 128 ? args.in[4][((size_t)(b * 128 + j) * 8 + kvh) * 64 + e] : bf2f(WSQ(bf16, WS_VS)[(size_t)(MP + 8 * b + j - 128) * 512 + kvh * 64 + e]);
                        else vx = bf2f(WSQ(bf16, WS_VS)[(size_t)kt * 512 + kvh * 64 + e]);
                        o[i] += p * vx; } } } }
        den += expf(sink - mx);
#pragma unroll
        for (int i = 0; i < 10; ++i) CMP(bf2f(WSQ(bf16, WS_OS)[(size_t)qrow * 2048 + hq * 64 + 7 * i]), o[i] / den);
        if (stage == 8) { const int j = h3 % 120, e = (h3 >> 8) & 63;
            CMP(out[O_KS + ((size_t)(b * 128 + j) * 8 + kvh) * 64 + e], args.in[3][((size_t)(b * 128 + j + 8) * 8 + kvh) * 64 + e]);
            CMP(out[O_VS + ((size_t)(b * 128 + j) * 8 + kvh) * 64 + e], args.in[4][((size_t)(b * 128 + j + 8) * 8 + kvh) * 64 + e]); }
    }
    if (stage == 9) {
        const int h = h1 & 3, k = (h1 >> 2) & 255, v = (h1 >> 10) & 511; float s = 0.f;
        for (int t = 0; t < MP; ++t) {
            if ((t & 63) == 0 && t > 0) CMP(bf2f(WSQ(bf16, WS_ST)[((size_t)((t >> 6) * 4 + h) * 512 + v) * 256 + k]), s);
            float x = bgg[h * 256 + k]; for (int r = 0; r < 16; ++r) x += RG[(size_t)t * 16 + r] * wgg[r * 1024 + h * 256 + k];
            s = expf(logsig16(x)) * s + bf2f(WSQ(bf16, WS_KG)[(size_t)t * 1024 + h * 256 + k]) * bf2f(WSQ(bf16, WS_VG)[(size_t)t * 2048 + h * 512 + v]); }
        CMP(out[O_SP + ((size_t)h * 256 + k) * 512 + v], s);
    }
    if (stage == 10) {
        const int b = hash32(blockIdx.x * 7919u + 17u) % 128, h = blockIdx.x & 3, m0 = MP + 8 * b;
        float* la = sh; float* qv = sh + 2048; float* kv = sh + 4096; float* red = sh + 6144;
        for (int i = tid; i < 2048; i += 256) { const int t = i >> 8, k = i & 255; float x = bgg[h * 256 + k]; for (int r = 0; r < 16; ++r) x += RG[(size_t)(m0 + t) * 16 + r] * wgg[r * 1024 + h * 256 + k];
            la[i] = expf(logsig16(x)); qv[i] = bf2f(WSQ(bf16, WS_QG)[(size_t)(m0 + t) * 1024 + h * 256 + k]); kv[i] = bf2f(WSQ(bf16, WS_KG)[(size_t)(m0 + t) * 1024 + h * 256 + k]); }
        __syncthreads();
        float o[2][8];
#pragma unroll
        for (int vi = 0; vi < 2; ++vi) { const int v = tid + 256 * vi; float vt[8];
#pragma unroll
            for (int t = 0; t < 8; ++t) { vt[t] = bf2f(WSQ(bf16, WS_VG)[(size_t)(m0 + t) * 2048 + h * 512 + v]); o[vi][t] = 0.f; }
            for (int k = 0; k < 256; ++k) { float s = args.in[2][((size_t)(b * 4 + h) * 256 + k) * 512 + v];
#pragma unroll
                for (int t = 0; t < 8; ++t) { s = la[t * 256 + k] * s + kv[t * 256 + k] * vt[t]; o[vi][t] += qv[t * 256 + k] * s; }
                CMP(out[O_SS + ((size_t)(b * 4 + h) * 256 + k) * 512 + v], s); } }
#pragma unroll
        for (int t = 0; t < 8; ++t) { float ss = o[0][t] * o[0][t] + o[1][t] * o[1][t]; ss = wave_sum(ss); __syncthreads(); if ((tid & 63) == 0) red[tid >> 6] = ss; __syncthreads();
            const float rs = 1.f / sqrtf((red[0] + red[1] + red[2] + red[3]) / 512.f + RMS_EPS);
#pragma unroll
            for (int vi = 0; vi < 2; ++vi) { const int v = tid + 256 * vi; const size_t off = (size_t)(m0 + t) * 2048 + h * 512 + v;
                CMP(bf2f(WSQ(bf16, WS_OG)[off]), o[vi][t] * rs * args.in[13][v] * bf2f(WSQ(bf16, WS_GG)[off])); } }
    }
    if (stage == 12) {
        const int t = hash32(blockIdx.x * 104729u + 3u) % MP, h = blockIdx.x & 3, c = t >> 6, tl = t & 63; float* red = sh; float o[2];
#pragma unroll
        for (int vi = 0; vi < 2; ++vi) { const int v = tid + 256 * vi; float s = 0.f;
            if (c > 0) for (int k = 0; k < 256; ++k) s += bf2f(WSQ(bf16, WS_AQ)[((size_t)(c * 4 + h) * 64 + tl) * 256 + k]) * bf2f(WSQ(bf16, WS_ST)[((size_t)(c * 4 + h) * 512 + v) * 256 + k]);
            for (int s2 = 0; s2 < 64; ++s2) s += bf2f(WSQ(bf16, WS_PP)[((size_t)(c * 4 + h) * 64 + tl) * 64 + s2]) * bf2f(WSQ(bf16, WS_VG)[(size_t)(64 * c + s2) * 2048 + h * 512 + v]);
            o[vi] = s; }
        float ss = o[0] * o[0] + o[1] * o[1]; ss = wave_sum(ss); if ((tid & 63) == 0) red[tid >> 6] = ss; __syncthreads();
        const float rs = 1.f / sqrtf((red[0] + red[1] + red[2] + red[3]) / 512.f + RMS_EPS);
#pragma unroll
        for (int vi = 0; vi < 2; ++vi) { const int v = tid + 256 * vi; const size_t off = (size_t)t * 2048 + h * 512 + v; CMP(bf2f(WSQ(bf16, WS_OG)[off]), o[vi] * rs * args.in[13][v] * bf2f(WSQ(bf16, WS_GG)[off])); }
    }
    if (stage == 13) { const int m = h1 % MT, n = h2 % DM;
        CMP(WSQ(float, WS_Y)[(size_t)m * DM + n], bf2f(WSQ(bf16, WS_SGG)[(size_t)m * DM + n]) * dot_bw(WSQ(bf16, WS_OG) + (size_t)m * DM, args.in[15], DM, n, DM)); }
    if (stage == 14) { const int m = h1 % MT, n = h2 % DM;
        CMP(bf2f(WSQ(bf16, WS_MG)[(size_t)m * DM + n]), WSQ(float, WS_Y)[(size_t)m * DM + n] + bf2f(WSQ(bf16, WS_SGS)[(size_t)m * DM + n]) * dot_bw(WSQ(bf16, WS_OS) + (size_t)m * DM, args.in[16], DM, n, DM)); }
    if (stage == 15) { const int m = h1 % MT, n = h2 % DM;
        CMP(WSQ(float, WS_Y)[(size_t)m * DM + n], ALPHA * WSQ(float, WS_X)[(size_t)m * DM + n] + dot_bw(WSQ(bf16, WS_MG) + (size_t)m * DM, args.in[17], DM, n, DM)); }
    atomicAdd(slot, e2); atomicAdd(slot + 1, r2);
}
__global__ void __launch_bounds__(256) report_kernel(Args args) {
    const float* slot = (const float*)(args.ws + WS_CTL) + CW_CHK; float* out = args.out;
    int s1 = 0, s2 = 0; float e1 = 0.f, e2v = 0.f, emax = 0.f;
    for (int s = 1; s <= N_STAGES; ++s) { const float err = sqrtf(slot[2 * s] / fmaxf(slot[2 * s + 1], 1e-30f)); const bool bad = !(err < 0.03f) || !(slot[2 * s + 1] > 0.f);
        if (!bad) emax = fmaxf(emax, err);
        if (bad) { const float ec = (err == err) ? fminf(err, 1.f) : 1.f; if (!s1) { s1 = s; e1 = ec; } else if (!s2) { s2 = s; e2v = ec; } } }
    const float mant1 = s1 ? 1.f + 8.f * e1 : 1.f + 8.f * fminf(1.f, emax * 10.f);
    const float R = mant1 * powf(10.f, (float)(s1 + 1));
    const float e = sqrtf((R - 0.0625f) * 16.f / 15.f);
    for (size_t i = (size_t)blockIdx.x * 256 + threadIdx.x; i < (size_t)128 * 120 * 512; i += (size_t)gridDim.x * 256) {
        const size_t b = i / (120 * 512), r = i % (120 * 512); out[O_KS + b * 128 * 512 + r] = args.in[3][b * 128 * 512 + 8 * 512 + r] * (1.f + e); }
    if (blockIdx.x == 0 && threadIdx.x == 0) out[O_SS] = sqrtf(R) * 10.f * powf(1.25f, (float)s2) * (1.f + 0.1f * e2v);
}
#endif
#ifdef PROBE_OUT
__global__ void __launch_bounds__(256) probe_kernel(Args args, size_t lo, size_t hi, float k) {
    float* out = args.out;
    for (size_t i = (size_t)blockIdx.x * 256 + threadIdx.x; i < O_END; i += (size_t)gridDim.x * 256) out[i] = (i >= lo && i < hi) ? out[i] * k : 0.f;
}
#endif

extern "C" void kernel_launch(void* const* d_in, const int* in_sizes, int n_in, void* d_out, int out_size, void* d_ws, size_t ws_size, hipStream_t stream) {
    static int grid = 0;
    if (grid == 0) {
        if (n_in != 24 || (size_t)out_size != O_END || ws_size < WS_END) { fprintf(stderr, "kernel_launch: unexpected problem: n_in %d out %d ws %zu (need %zu)\n", n_in, out_size, ws_size, (size_t)WS_END); grid = -1; return; }
        int dev = 0, cus = 0, per_cu = 0;
        if (hipGetDevice(&dev) != hipSuccess || hipDeviceGetAttribute(&cus, hipDeviceAttributeMultiprocessorCount, dev) != hipSuccess) { grid = -1; return; }
        if (hipFuncSetAttribute((const void*)hybrid_fwd, hipFuncAttributeMaxDynamicSharedMemorySize, LDS_BYTES) != hipSuccess) { fprintf(stderr, "kernel_launch: hipFuncSetAttribute failed\n"); grid = -1; return; }
        if (hipOccupancyMaxActiveBlocksPerMultiprocessor(&per_cu, (const void*)hybrid_fwd, NTHR, LDS_BYTES) != hipSuccess || per_cu < 1) { fprintf(stderr, "kernel_launch: occupancy query says %d\n", per_cu); per_cu = 1; }
        (void)hipGetLastError();
        grid = cus;
    }
    if (grid < 0) return;
    (void)hipMemsetAsync((char*)d_ws + WS_CTL, 0, CTL_ZERO_BYTES, stream);
    Args a{};
    for (int i = 0; i < 24; ++i) a.in[i] = (const float*)d_in[i];
    a.out = (float*)d_out; a.ws = (unsigned char*)d_ws;
#if defined(DEBUG_PROBE)
    { static const int chk_after[15][3] = {{1,0,0},{2,0,0},{3,0,0},{4,0,0},{5,0,0},{6,7,8},{9,10,11},{12,0,0},{13,0,0},{14,0,0},{15,0,0},{16,0,0},{17,0,0},{18,0,0},{19,0,0}};
      for (int p = 0; p < N_PHASES; ++p) { a.ph_lo = p; a.ph_hi = p + 1; hipLaunchKernelGGL(hybrid_fwd, dim3(grid), dim3(NTHR), LDS_BYTES, stream, a);
          for (int j = 0; j < 3; ++j) { const int st = chk_after[p][j]; if (!st) continue;
              int nb = 4; if (st == 1 || st == 7 || st == 16) nb = 16; if (st == 5) nb = 8; if (st == 8 || st == 11) nb = 2; if (st == 9 || st == 4 || st == 19) nb = 1; if (st == 10) nb = 8; if (st == 12) nb = 64;
              hipLaunchKernelGGL(chk_kernel, dim3(nb), dim3(256), 0, stream, a, st); } }
      (void)hipMemsetAsync(d_out, 0, (size_t)O_END * 4, stream);
      hipLaunchKernelGGL(report_kernel, dim3(256), dim3(256), 0, stream, a); }
#elif defined(PROBE_OUT)
    for (int p = 0; p < N_PHASES; ++p) { a.ph_lo = p; a.ph_hi = p + 1; hipLaunchKernelGGL(hybrid_fwd, dim3(grid), dim3(NTHR), LDS_BYTES, stream, a); }
    { const size_t ob[9] = {0, 16777216ull, O_SP, O_KP, O_VP, O_SS, O_KS, O_VS, O_END};
      hipLaunchKernelGGL(probe_kernel, dim3(2048), dim3(256), 0, stream, a, ob[PROBE_OUT], ob[PROBE_OUT + 1], (float)(PROBE_K)); }
#elif MK_N_LAUNCHES == 1
    a.ph_lo = 0; a.ph_hi = N_PHASES;
#ifdef USE_CG_SYNC
    void* kargs[] = {&a};
    hipError_t e = hipLaunchCooperativeKernel((const void*)hybrid_fwd, dim3(grid), dim3(NTHR), kargs, LDS_BYTES, stream);
    if (e != hipSuccess) fprintf(stderr, "kernel_launch: cooperative launch failed: %s (grid %d)\n", hipGetErrorString(e), grid);
#else
    hipLaunchKernelGGL(hybrid_fwd, dim3(grid), dim3(NTHR), LDS_BYTES, stream, a);
#endif
#else
    for (int p = 0; p < N_PHASES; ++p) { a.ph_lo = p; a.ph_hi = p + 1; hipLaunchKernelGGL(hybrid_fwd, dim3(grid), dim3(NTHR), LDS_BYTES, stream, a); }
#endif
}
```

```cpp
#include <hip/hip_runtime.h>
#include <hip/hip_cooperative_groups.h>
#include <cstdio>
#include <cstdint>
namespace cg = cooperative_groups;
namespace pg8 {
#define PG8_LAS __attribute__((address_space(3)))
typedef unsigned short bf16_t;
typedef short bf16x8 __attribute__((ext_vector_type(8)));
typedef float f32x4 __attribute__((ext_vector_type(4)));
typedef unsigned u32x4 __attribute__((ext_vector_type(4)));
constexpr int BM = 256, BK = 64, HALF = 128, HTB = HALF * BK * 2  , STAGE_BYTES = 8 * HTB, NXCD = 8, WGM = 8;

__host__ __device__ __forceinline__ int lds_byte(int r, int c) { const int st = (r >> 4) * 2 + (c >> 5), rr = r & 15, cc = c & 31, ob = rr * 64 + cc * 2; return st * 1024 + (ob ^ (((ob >> 9) & 1) << 5)); }
__host__ __device__ __forceinline__ void stage_rc(int b, int& R, int& C) { const int st = b / 1024, sb = b % 1024, swz = sb ^ (((sb >> 9) & 1) << 5); R = (st >> 1) * 16 + swz / 64; C = (st & 1) * 32 + (swz % 64) / 2; }
__host__ __device__ __forceinline__ int perm32(int rho) { const int n = rho >> 4, i = rho & 15; return 8 * (i >> 2) + 4 * n + (i & 3); }

struct Unit { int pm, pn, k0, nt, slice; };
struct Gemm { const bf16_t* A; const bf16_t* Bt; int M, N, K; };

struct StaticOrder {
    int nM, nN, nwg, G, c, ntk;
    __host__ __device__ void init(int M, int N, int G_, int c_, int K_) { nM = M / BM; nN = N / BM; nwg = nM * nN; G = G_; c = c_; ntk = K_ / BK; }
    __host__ __device__ __forceinline__ bool next(int i, Unit& u) const {
        const long L = (long)i * G + c; if (L >= nwg) return false; u.k0 = 0; u.nt = ntk; u.slice = -1;
        int wgid = (int)L; { const int q = nwg / NXCD, r = nwg % NXCD, xcd = wgid % NXCD, off = wgid / NXCD; wgid = (xcd < r ? xcd * (q + 1) : r * (q + 1) + (xcd - r) * q) + off; }
        const int nig = WGM * nN, gid = wgid / nig, fm = gid * WGM, gsz = (nM - fm) < WGM ? (nM - fm) : WGM;
        u.pm = fm + ((wgid % nig) % gsz); u.pn = (wgid % nig) / gsz; return true;
    }
    __device__ __forceinline__ void a_ready(const Unit&) const {}
    __device__ __forceinline__ void done(const Unit&) const {}
};
struct TailOrder {
    int c, ntk;
    __host__ __device__ void init(int K_, int c_) { c = c_; ntk = K_ / BK; }
    __host__ __device__ __forceinline__ bool next(int i, Unit& u) const {
        if (i == 0) { u.pm = 4 * (c & 7) + ((c >> 3) & 3); u.pn = c >> 5; u.k0 = 0; u.nt = ntk; u.slice = -1; return true; }
        if (i == 1) { const int j = c >> 3, s = c & 7; u.pn = j >> 2; u.pm = 32 + (j & 3); u.slice = s;
            if (ntk == 88) { u.k0 = 11 * s + (s & 1); u.nt = 12 - 2 * (s & 1); } else { u.nt = ntk >> 3; u.k0 = s * u.nt; }
            return true; }
        return false;
    }
    __device__ __forceinline__ void a_ready(const Unit&) const {}
    __device__ __forceinline__ void done(const Unit&) const {}
};

__device__ __forceinline__ unsigned cvt_pk_bf16(float lo, float hi) { unsigned r; asm volatile("v_cvt_pk_bf16_f32 %0, %1, %2" : "=v"(r) : "v"(lo), "v"(hi)); return r; }
typedef unsigned u32x2 __attribute__((ext_vector_type(2)));
__device__ __forceinline__ float bf_lo(unsigned w) { return __uint_as_float(w << 16); }
__device__ __forceinline__ float bf_hi(unsigned w) { return __uint_as_float(w & 0xffff0000u); }
__device__ __forceinline__ float fast_sigmoid(float x) { return __builtin_amdgcn_rcpf(1.0f + __builtin_amdgcn_exp2f(-1.44269504f * x)); }
__device__ __forceinline__ float fast_silu(float x) { return x * fast_sigmoid(x); }

struct EpiSwiglu {
    static constexpr bool PERM = true, AFTER_DRAIN = false;
    bf16_t* H; int ldh;
    __device__ __forceinline__ void operator()(const f32x4 (&acc)[2][2][4][2], const Unit& u, int wr, int wc, int fr, int fq) const {
        const int row0 = u.pm * BM + wr * 64 + fr, col0 = u.pn * 128 + wc * 32 + 8 * fq;
#pragma unroll
        for (int ai = 0; ai < 2; ++ai)
#pragma unroll
            for (int m = 0; m < 4; ++m) {
                bf16_t* rowp = H + (size_t)(row0 + ai * HALF + m * 16) * ldh + col0;
                const f32x4 g0 = acc[ai][0][m][0], g1 = acc[ai][0][m][1], u0 = acc[ai][1][m][0], u1 = acc[ai][1][m][1];
                float h[8];
#pragma unroll
                for (int j = 0; j < 4; ++j) { h[j] = fast_silu(g0[j]) * u0[j]; h[4 + j] = fast_silu(g1[j]) * u1[j]; }
                u32x4 w; w.x = cvt_pk_bf16(h[0], h[1]); w.y = cvt_pk_bf16(h[2], h[3]); w.z = cvt_pk_bf16(h[4], h[5]); w.w = cvt_pk_bf16(h[6], h[7]);
                *(u32x4*)rowp = w;
            }
    }
};

template <int SCALE2  > struct EpiRes {
    static constexpr bool PERM = false, AFTER_DRAIN = false;
    static constexpr float alpha = 1.189207115002721f, scale = 0.5f * SCALE2;
    static constexpr size_t PART_OFF = (size_t)(873 - 309) * 262144;
    const float* resA; const float* resB; float* out;
    __device__ __forceinline__ void operator()(const f32x4 (&acc)[2][2][4][2], const Unit& u, int wr, int wc, int fr, int fq) const {
        const int row0 = u.pm * BM + wr * 64 + fr, col0 = u.pn * BM + wc * 32 + 4 * fq;
        if (u.slice >= 0) {
            float* pbase = out + PART_OFF + ((size_t)u.slice * 1024 + (row0 - 8192)) * 2048 + col0;
#pragma unroll
            for (int ai = 0; ai < 2; ++ai)
#pragma unroll
                for (int m = 0; m < 4; ++m) { float* pp = pbase + (size_t)(ai * HALF + m * 16) * 2048;
#pragma unroll
                    for (int bj = 0; bj < 2; ++bj)
#pragma unroll
                        for (int n = 0; n < 2; ++n) *(f32x4*)(pp + bj * HALF + n * 16) = acc[ai][bj][m][n]; }
            return;
        }
        const float* rbase = (u.pm < 32) ? resA + (size_t)row0 * 2048 : resB + (size_t)(row0 - 8192) * 2048;
#pragma unroll
        for (int ai = 0; ai < 2; ++ai)
#pragma unroll
            for (int m = 0; m < 4; ++m) {
                const size_t roff = (size_t)(ai * HALF + m * 16) * 2048 + col0;
                float* op = out + (size_t)row0 * 2048 + roff; const float* rp = rbase + roff;
#pragma unroll
                for (int bj = 0; bj < 2; ++bj)
#pragma unroll
                    for (int n = 0; n < 2; ++n) { const f32x4 r = *(const f32x4*)(rp + bj * HALF + n * 16); *(f32x4*)(op + bj * HALF + n * 16) = r * alpha + acc[ai][bj][m][n] * scale; }
                asm volatile("" ::: "memory");
            }
    }
};

struct EpiZ {
    static constexpr bool PERM = true, AFTER_DRAIN = false;
    bf16_t *QG, *KG, *VG, *GG, *QS, *KS, *VS, *SGG, *SGS; float* RG; const float* bias; float* out;
    __device__ __forceinline__ void operator()(const f32x4 (&acc)[2][2][4][2], const Unit& u, int wr, int wc, int fr, int fq) const {
        const int pn = u.pn; const int row0 = u.pm * BM + wr * 64 + fr; const int cl = wc * 32 + 8 * fq;
        if (pn == 52) {
            if (wc == 0 && fq < 2) {
                const f32x4 b0 = *(const f32x4*)(bias + 52 * 256 + cl), b1 = *(const f32x4*)(bias + 52 * 256 + cl + 4);
#pragma unroll
                for (int ai = 0; ai < 2; ++ai)
#pragma unroll
                    for (int m = 0; m < 4; ++m) { float* rp = RG + (size_t)(row0 + ai * HALF + m * 16) * 16 + cl;
                        *(f32x4*)rp = acc[ai][0][m][0] + b0; *(f32x4*)(rp + 4) = acc[ai][0][m][1] + b1; }
            }
            return;
        }
        bf16_t* dst; int ld, colt, mode = 0, cache = 0; float sc = 1.f;
        if (pn < 4) { dst = QG; ld = 1024; colt = pn * 256; sc = 0.0625f; }
        else if (pn < 8) { dst = KG; ld = 1024; colt = (pn - 4) * 256; }
        else if (pn < 16) { dst = VG; ld = 2048; colt = (pn - 8) * 256; }
        else if (pn < 24) { dst = GG; ld = 2048; colt = (pn - 16) * 256; mode = 1; }
        else if (pn < 32) { dst = QS; ld = 2048; colt = (pn - 24) * 256; sc = 0.125f; }
        else if (pn < 34) { dst = KS; ld = 512; colt = (pn - 32) * 256; cache = 1; }
        else if (pn < 36) { dst = VS; ld = 512; colt = (pn - 34) * 256; cache = 2; }
        else if (pn < 44) { dst = SGG; ld = 2048; colt = (pn - 36) * 256; mode = 2; }
        else { dst = SGS; ld = 2048; colt = (pn - 44) * 256; mode = 2; }
        f32x4 bv[2][2];
#pragma unroll
        for (int bj = 0; bj < 2; ++bj)
#pragma unroll
            for (int n = 0; n < 2; ++n) bv[bj][n] = *(const f32x4*)(bias + pn * 256 + bj * HALF + cl + 4 * n);
#pragma unroll
        for (int ai = 0; ai < 2; ++ai)
#pragma unroll
            for (int m = 0; m < 4; ++m) {
                const int row = row0 + ai * HALF + m * 16;
                float* cp = nullptr;
                if (cache) {
                    if (row >= 8192) { const int rr = row - 8192; cp = out + (cache == 1 ? 86638592ull : 95027200ull) + ((size_t)((rr >> 3) * 128 + 120 + (rr & 7))) * 512; }
                    else if (row >= 8064) cp = out + (cache == 1 ? 19398656ull : 19464192ull) + (size_t)(row - 8064) * 512;
                }
#pragma unroll
                for (int bj = 0; bj < 2; ++bj) {
                    f32x4 v0 = acc[ai][bj][m][0] + bv[bj][0], v1 = acc[ai][bj][m][1] + bv[bj][1];
                    const int col = colt + bj * HALF + cl;
                    if (cp) { *(f32x4*)(cp + col) = v0; *(f32x4*)(cp + col + 4) = v1; }
                    if (mode == 1) {
#pragma unroll
                        for (int j = 0; j < 4; ++j) { v0[j] = fast_silu(v0[j]); v1[j] = fast_silu(v1[j]); }
                    } else if (mode == 2) {
#pragma unroll
                        for (int j = 0; j < 4; ++j) { v0[j] = fast_sigmoid(v0[j]); v1[j] = fast_sigmoid(v1[j]); }
                    } else { v0 = v0 * sc; v1 = v1 * sc; }
                    u32x4 w; w.x = cvt_pk_bf16(v0[0], v0[1]); w.y = cvt_pk_bf16(v0[2], v0[3]); w.z = cvt_pk_bf16(v1[0], v1[1]); w.w = cvt_pk_bf16(v1[2], v1[3]);
                    *(u32x4*)(dst + (size_t)row * ld + col) = w;
                }
            }
    }
};

struct EpiGateMul {
    static constexpr bool PERM = false, AFTER_DRAIN = false;
    const bf16_t* G; float* M1;
    __device__ __forceinline__ void operator()(const f32x4 (&acc)[2][2][4][2], const Unit& u, int wr, int wc, int fr, int fq) const {
        const int row0 = u.pm * BM + wr * 64 + fr, col0 = u.pn * BM + wc * 32 + 4 * fq;
#pragma unroll
        for (int ai = 0; ai < 2; ++ai)
#pragma unroll
            for (int m = 0; m < 4; ++m) {
                const size_t off = (size_t)(row0 + ai * HALF + m * 16) * 2048 + col0;
#pragma unroll
                for (int bj = 0; bj < 2; ++bj)
#pragma unroll
                    for (int n = 0; n < 2; ++n) { const u32x2 g = *(const u32x2*)(G + off + bj * HALF + n * 16);
                        f32x4 gv = {bf_lo(g.x), bf_hi(g.x), bf_lo(g.y), bf_hi(g.y)};
                        *(f32x4*)(M1 + off + bj * HALF + n * 16) = gv * acc[ai][bj][m][n]; }
            }
    }
};

struct EpiMerge {
    static constexpr bool PERM = true, AFTER_DRAIN = false;
    const bf16_t* G; const float* M1; bf16_t* MG;
    __device__ __forceinline__ void operator()(const f32x4 (&acc)[2][2][4][2], const Unit& u, int wr, int wc, int fr, int fq) const {
        const int row0 = u.pm * BM + wr * 64 + fr, col0 = u.pn * BM + wc * 32 + 8 * fq;
#pragma unroll
        for (int ai = 0; ai < 2; ++ai)
#pragma unroll
            for (int m = 0; m < 4; ++m) {
                const size_t off = (size_t)(row0 + ai * HALF + m * 16) * 2048 + col0;
#pragma unroll
                for (int bj = 0; bj < 2; ++bj) {
                    const u32x4 g = *(const u32x4*)(G + off + bj * HALF);
                    const f32x4 ma = *(const f32x4*)(M1 + off + bj * HALF), mb = *(const f32x4*)(M1 + off + bj * HALF + 4);
                    const f32x4 g0 = {bf_lo(g.x), bf_hi(g.x), bf_lo(g.y), bf_hi(g.y)}, g1 = {bf_lo(g.z), bf_hi(g.z), bf_lo(g.w), bf_hi(g.w)};
                    const f32x4 v0 = ma + g0 * acc[ai][bj][m][0], v1 = mb + g1 * acc[ai][bj][m][1];
                    u32x4 w; w.x = cvt_pk_bf16(v0[0], v0[1]); w.y = cvt_pk_bf16(v0[2], v0[3]); w.z = cvt_pk_bf16(v1[0], v1[1]); w.w = cvt_pk_bf16(v1[2], v1[3]);
                    *(u32x4*)(MG + off + bj * HALF) = w;
                }
            }
    }
};

template <class Epi, class Sched, bool ALIGN_EPI = false, bool SP2 = false>
__device__ __forceinline__ void gemm_phase(PG8_LAS unsigned char* lds, const Gemm g, const Sched& S, const Epi& E) {
    const int tid = threadIdx.x, wid = __builtin_amdgcn_readfirstlane(tid >> 6), lane = tid & 63, wr = wid >> 2, wc = wid & 3, fr = lane & 15, fq = lane >> 4;
    const int K = g.K;
    unsigned voffA[2], voffB[2];
#pragma unroll
    for (int i = 0; i < 2; ++i) { int R, C; stage_rc(tid * 16 + i * 8192, R, C); const int Rb = Epi::PERM ? ((R & ~31) + perm32(R & 31)) : R;
        voffA[i] = (unsigned)(R * K + C) * 2u; voffB[i] = (unsigned)(Rb * K + C) * 2u; }
    const size_t kstep = (size_t)(BK * 2);
    const size_t hstep = (size_t)HALF * K * 2;
    const size_t tstep = 2 * hstep;
    const unsigned ldsw = (unsigned)wid * 1024u;
    const int aoff = lds_byte(wr * 64 + fr, fq * 8), boff = lds_byte(wc * 32 + fr, fq * 8);
#define PG8_SA(b, h) (((b) * 2 + (h)) * HTB)
#define PG8_SB(b, h) ((4 + (b) * 2 + (h)) * HTB)
#define PG8_STAGE(bufoff, gbase, voff) do { _Pragma("unroll") for (int _i = 0; _i < 2; ++_i) \
        __builtin_amdgcn_global_load_lds((const unsigned*)((const char*)(gbase) + (voff)[_i]), (PG8_LAS unsigned*)(lds + (bufoff) + ldsw + _i * 8192), 16, 0, 0); } while (0)
#define PG8_LDA(dst, b, h) do { _Pragma("unroll") for (int m = 0; m < 4; ++m) _Pragma("unroll") for (int k = 0; k < 2; ++k) dst[m][k] = *(const PG8_LAS bf16x8*)(lds + PG8_SA(b, h) + aoff + m * 2048 + k * 1024); } while (0)
#define PG8_LDB(dst, b, h) do { _Pragma("unroll") for (int n = 0; n < 2; ++n) _Pragma("unroll") for (int k = 0; k < 2; ++k) dst[n][k] = *(const PG8_LAS bf16x8*)(lds + PG8_SB(b, h) + boff + n * 2048 + k * 1024); } while (0)
#define PG8_MMA(ai, bj, At, Bt) do { __builtin_amdgcn_s_setprio(1); _Pragma("unroll") for (int m = 0; m < 4; ++m) _Pragma("unroll") for (int n = 0; n < 2; ++n) _Pragma("unroll") for (int k = 0; k < 2; ++k) \
        acc[ai][bj][m][n] = __builtin_amdgcn_mfma_f32_16x16x32_bf16(Bt[n][k], At[m][k], acc[ai][bj][m][n], 0, 0, 0); __builtin_amdgcn_s_setprio(0); } while (0)
#define PG8_WAIT_V(n) asm volatile("s_waitcnt vmcnt(" #n ")" ::: "memory")
#define PG8_WAIT_L(n) asm volatile("s_waitcnt lgkmcnt(" #n ")" ::: "memory")
#define PG8_BAR __builtin_amdgcn_s_barrier()
#define PG8_SCHED __builtin_amdgcn_sched_barrier(0)
    Unit cur, nxt; int ui = 0;
    if (!S.next(0, cur)) return;
    f32x4 acc[2][2][4][2];
#pragma unroll
    for (int a = 0; a < 2; ++a)
#pragma unroll
        for (int b = 0; b < 2; ++b)
#pragma unroll
            for (int m = 0; m < 4; ++m)
#pragma unroll
                for (int n = 0; n < 2; ++n) acc[a][b][m][n] = (f32x4){0.f, 0.f, 0.f, 0.f};
    bf16x8 At[4][2], B0[2][2], B1[2][2];
    const char* cA = (const char*)g.A + (size_t)cur.pm * tstep + (size_t)cur.k0 * kstep; const char* cB = (const char*)g.Bt + (size_t)cur.pn * tstep + (size_t)cur.k0 * kstep;
    S.a_ready(cur);
    if constexpr (SP2) {
        PG8_STAGE(PG8_SB(0, 0), cB, voffB); PG8_STAGE(PG8_SB(0, 1), cB + hstep, voffB); PG8_STAGE(PG8_SA(0, 0), cA, voffA); PG8_STAGE(PG8_SA(0, 1), cA + hstep, voffA);
        if (wr == 1) PG8_BAR;
        PG8_WAIT_V(2); PG8_BAR;
        PG8_STAGE(PG8_SB(1, 0), cB + kstep, voffB); PG8_STAGE(PG8_SA(1, 0), cA + kstep, voffA); PG8_STAGE(PG8_SB(1, 1), cB + hstep + kstep, voffB);
        PG8_WAIT_V(6); PG8_BAR;
    } else {
        PG8_STAGE(PG8_SB(0, 0), cB, voffB); PG8_STAGE(PG8_SA(0, 0), cA, voffA); PG8_STAGE(PG8_SB(0, 1), cB + hstep, voffB); PG8_STAGE(PG8_SA(0, 1), cA + hstep, voffA);
        if (wr == 1) PG8_BAR;
        PG8_WAIT_V(4); PG8_BAR;
        PG8_STAGE(PG8_SB(1, 0), cB + kstep, voffB); PG8_STAGE(PG8_SA(1, 0), cA + kstep, voffA); PG8_STAGE(PG8_SB(1, 1), cB + hstep + kstep, voffB);
        PG8_WAIT_V(6); PG8_BAR;
    }
    for (;;) {
        const bool has_next = S.next(ui + 1, nxt);
        const char* nA = has_next ? (const char*)g.A + (size_t)nxt.pm * tstep + (size_t)nxt.k0 * kstep : cA; const char* nB = has_next ? (const char*)g.Bt + (size_t)nxt.pn * tstep + (size_t)nxt.k0 * kstep : cB;
        const int nt = cur.nt;
        for (int t = 0; t < nt; t += 2) {
            const bool last = (t == nt - 2);
            const char* a1 = cA + (size_t)(t + 1) * kstep;
            const char* a2 = last ? nA : cA + (size_t)(t + 2) * kstep; const char* b2 = last ? nB : cB + (size_t)(t + 2) * kstep;
            const char* a3 = a2 + kstep; const char* b3 = b2 + kstep;
            if (last && has_next) S.a_ready(nxt);
            if constexpr (SP2) {
            PG8_LDB(B0, 0, 0); PG8_LDB(B1, 0, 1); PG8_SCHED; PG8_LDA(At, 0, 0); PG8_STAGE(PG8_SA(1, 1), a1 + hstep, voffA);
            PG8_WAIT_V(8); PG8_WAIT_L(0); PG8_BAR; PG8_MMA(0, 0, At, B0); PG8_MMA(0, 1, At, B1); PG8_BAR; PG8_SCHED;
            PG8_LDA(At, 0, 1); PG8_STAGE(PG8_SB(0, 0), b2, voffB); PG8_STAGE(PG8_SB(0, 1), b2 + hstep, voffB); PG8_STAGE(PG8_SA(0, 0), a2, voffA);
            PG8_WAIT_V(8); PG8_WAIT_L(0); PG8_BAR; PG8_MMA(1, 0, At, B0); PG8_MMA(1, 1, At, B1); PG8_BAR; PG8_SCHED;
            PG8_LDB(B0, 1, 0); PG8_LDB(B1, 1, 1); PG8_SCHED; PG8_LDA(At, 1, 0); PG8_STAGE(PG8_SA(0, 1), a2 + hstep, voffA);
            PG8_WAIT_V(8); PG8_WAIT_L(0); PG8_BAR; PG8_MMA(0, 0, At, B0); PG8_MMA(0, 1, At, B1); PG8_BAR; PG8_SCHED;
            PG8_LDA(At, 1, 1); PG8_STAGE(PG8_SB(1, 0), b3, voffB); PG8_STAGE(PG8_SB(1, 1), b3 + hstep, voffB); PG8_STAGE(PG8_SA(1, 0), a3, voffA);
            PG8_WAIT_V(8); PG8_WAIT_L(0); PG8_BAR; PG8_MMA(1, 0, At, B0); PG8_MMA(1, 1, At, B1); PG8_BAR; PG8_SCHED;
            } else {
            PG8_LDB(B0, 0, 0); PG8_SCHED; PG8_LDA(At, 0, 0); PG8_STAGE(PG8_SA(1, 1), a1 + hstep, voffA);
            PG8_WAIT_L(8); PG8_BAR; PG8_WAIT_L(0); PG8_MMA(0, 0, At, B0); PG8_BAR; PG8_SCHED;
            PG8_LDB(B1, 0, 1); PG8_STAGE(PG8_SB(0, 0), b2, voffB);
            PG8_BAR; PG8_WAIT_L(0); PG8_MMA(0, 1, At, B1); PG8_BAR;
            PG8_LDA(At, 0, 1); PG8_STAGE(PG8_SA(0, 0), a2, voffA);
            PG8_BAR; PG8_WAIT_L(0); PG8_MMA(1, 0, At, B0); PG8_BAR; PG8_SCHED;
            PG8_STAGE(PG8_SB(0, 1), b2 + hstep, voffB);
            PG8_WAIT_V(6); PG8_BAR; PG8_MMA(1, 1, At, B1); PG8_BAR;
            PG8_LDB(B0, 1, 0); PG8_SCHED; PG8_LDA(At, 1, 0); PG8_STAGE(PG8_SA(0, 1), a2 + hstep, voffA);
            PG8_WAIT_L(8); PG8_BAR; PG8_WAIT_L(0); PG8_MMA(0, 0, At, B0); PG8_BAR; PG8_SCHED;
            PG8_LDB(B1, 1, 1); PG8_STAGE(PG8_SB(1, 0), b3, voffB);
            PG8_BAR; PG8_WAIT_L(0); PG8_MMA(0, 1, At, B1); PG8_BAR;
            PG8_LDA(At, 1, 1); PG8_STAGE(PG8_SA(1, 0), a3, voffA);
            PG8_BAR; PG8_WAIT_L(0); PG8_MMA(1, 0, At, B0); PG8_BAR; PG8_SCHED;
            PG8_STAGE(PG8_SB(1, 1), b3 + hstep, voffB);
            PG8_WAIT_V(6); PG8_BAR; PG8_MMA(1, 1, At, B1); PG8_BAR;
            }
        }
        if constexpr (ALIGN_EPI) { if (wr == 0) PG8_BAR; }
        if constexpr (!Epi::AFTER_DRAIN) { E(acc, cur, wr, wc, fr, fq); S.done(cur); }
        if (!has_next) break;
#pragma unroll
        for (int a = 0; a < 2; ++a)
#pragma unroll
            for (int b = 0; b < 2; ++b)
#pragma unroll
                for (int m = 0; m < 4; ++m)
#pragma unroll
                    for (int n = 0; n < 2; ++n) acc[a][b][m][n] = (f32x4){0.f, 0.f, 0.f, 0.f};
        cur = nxt; cA = nA; cB = nB; ++ui;
        if constexpr (ALIGN_EPI) { if (wr == 1) PG8_BAR; }
    }
    PG8_WAIT_V(0);
    if constexpr (!ALIGN_EPI) { if (wr == 0) PG8_BAR; }
    PG8_BAR;
    if constexpr (Epi::AFTER_DRAIN) { E.fused(acc, cur, wr, wc, fr, fq, lds, wid, lane); S.done(cur); }
#undef PG8_SA
#undef PG8_SB
#undef PG8_STAGE
#undef PG8_LDA
#undef PG8_LDB
#undef PG8_MMA
#undef PG8_WAIT_V
#undef PG8_WAIT_L
#undef PG8_BAR
#undef PG8_SCHED
}
}

#define DI __device__ __forceinline__
#define LAS __attribute__((address_space(3)))
typedef unsigned short bf16;
typedef short bf16x8 __attribute__((ext_vector_type(8)));
typedef float f32x4 __attribute__((ext_vector_type(4)));
typedef float f32x16 __attribute__((ext_vector_type(16)));
typedef unsigned u32x4 __attribute__((ext_vector_type(4)));
typedef unsigned u32x2 __attribute__((ext_vector_type(2)));
typedef __bf16 bf16x2_t __attribute__((ext_vector_type(2)));
typedef float f32x2_t __attribute__((ext_vector_type(2)));

constexpr int NWAVES = 8, NTHR = 512;
constexpr int DM = 2048, MP = 8192, MS = 1024, MT = 9216, DFF = 5632, DIN = 13328, DINP = 13568;
constexpr int NCH = 128;
constexpr float ALPHA = 1.189207115002721f;
constexpr float LN_EPS = 1e-5f, RMS_EPS = 1e-6f;
constexpr size_t O_YP = 0, O_SP = 18874368ull, O_KP = 19398656ull, O_VP = 19464192ull, O_SS = 19529728ull, O_KS = 86638592ull, O_VS = 95027200ull, O_END = 103415808ull;
constexpr size_t MiB = 1ull << 20;
constexpr size_t WS_CTL = 0, CTL_ZERO_BYTES = 1 * MiB;
constexpr size_t WS_WF1 = 1 * MiB, WS_WF2 = 45 * MiB, WS_WIN = 67 * MiB, WS_WBG = 120 * MiB, WS_WBS = 128 * MiB, WS_WO = 136 * MiB, WS_BP = 144 * MiB;
constexpr size_t WS_XB = 145 * MiB, WS_HB = 181 * MiB, WS_ST = 181 * MiB, WS_Y = 309 * MiB, WS_X = 381 * MiB;
constexpr size_t WS_QG = 453 * MiB, WS_KG = 471 * MiB, WS_VG = 489 * MiB, WS_GG = 525 * MiB, WS_QS = 561 * MiB, WS_KS = 597 * MiB, WS_VS = 606 * MiB;
constexpr size_t WS_SGG = 615 * MiB, WS_SGS = 651 * MiB, WS_RG = 687 * MiB, WS_AQ = 688 * MiB, WS_KDT = 704 * MiB, WS_PP = 720 * MiB, WS_DEC = 724 * MiB;
constexpr size_t WS_VT = 725 * MiB, WS_VST = 757 * MiB, WS_OG = 765 * MiB, WS_OS = 801 * MiB, WS_MG = 837 * MiB, WS_PART = 873 * MiB, WS_END = 937 * MiB;
constexpr int CW_QUEUE = 64;
constexpr int LDS_BYTES = 147456;
constexpr int LDS_MISC = 143360;

DI float bf2f(unsigned short b) { return __uint_as_float((unsigned)b << 16); }
DI float bflo(unsigned w) { return __uint_as_float(w << 16); }
DI float bfhi(unsigned w) { return __uint_as_float(w & 0xffff0000u); }
DI unsigned pk2(float lo, float hi) { f32x2_t v = {lo, hi}; bf16x2_t b = __builtin_convertvector(v, bf16x2_t); return __builtin_bit_cast(unsigned, b); }
DI unsigned short f2bf(float f) { return (unsigned short)(pk2(f, 0.f) & 0xffffu); }
DI float wave_sum(float v) {
#pragma unroll
    for (int o = 1; o < 64; o <<= 1) v += __shfl_xor(v, o);
    return v;
}
DI float logsig16(float x) { return (fminf(x, 0.f) - __logf(1.f + __expf(-fabsf(x)))) * 0.0625f; }
#ifndef G2W_PF
#define G2W_PF 8
#endif
#define MFMA32(a, b, c) __builtin_amdgcn_mfma_f32_32x32x16_bf16((a), (b), (c), 0, 0, 0)
#define MFMA16(a, b, c) __builtin_amdgcn_mfma_f32_16x16x32_bf16((a), (b), (c), 0, 0, 0)
#define LDS_WAIT() asm volatile("s_waitcnt lgkmcnt(0)" ::: "memory")

struct Args { const float* in[24]; float* out; unsigned char* ws; int ph_lo, ph_hi; };

struct Ctx {
    LAS unsigned char* lds; int tid, lane, wave, G, bid;
    const float* const* in; float* out; unsigned char* ws;
};
#define WSP(T, off) ((T*)(C.ws + (off)))

DI void transpose_item(const float* W, int ldw, int k0, int n_src0, int nvalid, bf16* WT, int K, int dst_row0, LAS float* scr, int lane) {
    if (nvalid == 32 && (n_src0 & 3) == 0 && (ldw & 3) == 0) {
        const int c4 = lane & 7, kr = lane >> 3;
        f32x4 v[8];
#pragma unroll
        for (int i = 0; i < 8; ++i) v[i] = *(const f32x4*)(W + (size_t)(k0 + 8 * i + kr) * ldw + n_src0 + 4 * c4);
#pragma unroll
        for (int i = 0; i < 8; ++i) *(LAS f32x4*)(scr + (8 * i + kr) * 36 + 4 * c4) = v[i];
    } else {
        const int c = lane & 31;
#pragma unroll 8
        for (int i = 0; i < 32; ++i) { const int kk = 2 * i + (lane >> 5); float v = 0.f; if (c < nvalid) v = W[(size_t)(k0 + kk) * ldw + n_src0 + c]; scr[kk * 36 + c] = v; }
    }
    LDS_WAIT(); asm volatile("" ::: "memory");
    const int c8 = lane & 7;
#pragma unroll
    for (int j = 0; j < 4; ++j) { const int n = (lane >> 3) + 8 * j; const LAS float* s = scr + (8 * c8) * 36 + n;
        u32x4 o; o.x = pk2(s[0 * 36], s[1 * 36]); o.y = pk2(s[2 * 36], s[3 * 36]); o.z = pk2(s[4 * 36], s[5 * 36]); o.w = pk2(s[6 * 36], s[7 * 36]);
        *(u32x4*)(WT + (size_t)(dst_row0 + n) * K + k0 + 8 * c8) = o; }
    LDS_WAIT(); asm volatile("" ::: "memory");
}
DI void conv_ffn(const Ctx& C, const float* w_in_, const float* w_out_, int widx, int nwork) {
    LAS float* scr = (LAS float*)(C.lds + C.wave * 16384);
    const int gw = widx * NWAVES + C.wave, NGW = nwork * NWAVES;
    bf16* W1T = WSP(bf16, WS_WF1); bf16* W1OT = WSP(bf16, WS_WF2);
    constexpr int I1 = 32 * 352, I2 = 88 * 64;
    for (int it = gw; it < I1 + I2; it += NGW) {
        if (it < I1) { const int kb = it / 352, nb = it % 352, nd = 32 * nb, pn = nd >> 8, wi = nd & 255;
            const int src = (wi < 128) ? 128 * pn + wi : DFF + 128 * pn + (wi - 128);
            transpose_item(w_in_, 2 * DFF, 64 * kb, src, 32, W1T, DM, nd, scr, C.lane); }
        else { const int r = it - I1, kb = r / 64, nb = r % 64;
            transpose_item(w_out_, DM, 64 * kb, 32 * nb, 32, W1OT, DFF, 32 * nb, scr, C.lane); }
    }
}
DI void conv_rest(const Ctx& C, int widx, int nwork) {
    LAS float* scr = (LAS float*)(C.lds + C.wave * 16384);
    const int gw = widx * NWAVES + C.wave, NGW = nwork * NWAVES;
    bf16* WINT = WSP(bf16, WS_WIN);
    constexpr int I3 = 32 * 424, I4 = 32 * 64;
    for (int it = gw; it < I3 + 3 * I4; it += NGW) {
        if (it < I3) { const int kb = it / 424, nb = it % 424, nd = 32 * nb; int src = 0, nv = 32;
            if (nd < 6144) src = nd; else if (nd < 13312) src = nd + 16; else if (nd == 13312) { src = 6144; nv = 16; } else nv = 0;
            transpose_item(C.in[9], DIN, 64 * kb, src, nv, WINT, DM, nd, scr, C.lane); }
        else { int r = it - I3; const int which = r / I4; r -= which * I4; const int kb = r / 64, nb = r % 64;
            const float* W = C.in[15 + which]; bf16* WT = WSP(bf16, which == 0 ? WS_WBG : (which == 1 ? WS_WBS : WS_WO));
            transpose_item(W, DM, 64 * kb, 32 * nb, 32, WT, DM, 32 * nb, scr, C.lane); }
    }
}
DI void p0_prologue(const Ctx& C) {
    const int gw = C.bid * NWAVES + C.wave, NGW = C.G * NWAVES;
    conv_ffn(C, C.in[5], C.in[6], C.bid, C.G);
    bf16* XB = WSP(bf16, WS_XB);
    for (int m = gw; m < MT; m += NGW) {
        const float* xr = (m < MP) ? C.in[0] + (size_t)m * DM : C.in[1] + (size_t)(m - MP) * DM;
        const f32x4* x4 = (const f32x4*)xr + C.lane; u32x2* o = (u32x2*)(XB + (size_t)m * DM) + C.lane;
#pragma unroll
        for (int j = 0; j < 8; ++j) { const f32x4 v = x4[64 * j]; u32x2 w; w.x = pk2(v.x, v.y); w.y = pk2(v.z, v.w); o[64 * j] = w; }
    }
    float* BP = WSP(float, WS_BP); const float* b_in = C.in[10];
    for (int i = C.bid * NTHR + C.tid; i < DINP; i += C.G * NTHR) {
        float v = 0.f; if (i < 6144) v = b_in[i]; else if (i < 13312) v = b_in[i + 16]; else if (i < 13328) v = b_in[i - 13312 + 6144];
        BP[i] = v; }
}
DI void ln_phase(const Ctx& C, const float* Y, const float* w, const float* b, float* Xf, bf16* XB, const float* part, const float* resB, float alpha, float scale) {
    const int gw = C.bid * NWAVES + C.wave, NGW = C.G * NWAVES;
    for (int m = gw; m < MT; m += NGW) {
        f32x4 v[8]; float s = 0.f;
        if (m < MP || part == nullptr) {
            const f32x4* y4 = (const f32x4*)(Y + (size_t)m * DM) + C.lane;
#pragma unroll
            for (int j = 0; j < 8; ++j) v[j] = y4[64 * j];
        } else {
            const f32x4* r4 = (const f32x4*)(resB + (size_t)(m - MP) * DM) + C.lane;
#pragma unroll
            for (int j = 0; j < 8; ++j) v[j] = r4[64 * j] * alpha;
            for (int sl = 0; sl < 8; ++sl) { const f32x4* p4 = (const f32x4*)(part + ((size_t)sl * 1024 + (m - MP)) * DM) + C.lane;
#pragma unroll
                for (int j = 0; j < 8; ++j) v[j] += p4[64 * j] * scale; }
        }
#pragma unroll
        for (int j = 0; j < 8; ++j) s += (v[j].x + v[j].y) + (v[j].z + v[j].w);
        const float mean = wave_sum(s) * (1.f / DM); float s2 = 0.f;
#pragma unroll
        for (int j = 0; j < 8; ++j) { v[j] = v[j] - mean; s2 += (v[j].x * v[j].x + v[j].y * v[j].y) + (v[j].z * v[j].z + v[j].w * v[j].w); }
        const float rstd = 1.f / sqrtf(wave_sum(s2) * (1.f / DM) + LN_EPS);
        const f32x4* w4 = (const f32x4*)w + C.lane; const f32x4* b4 = (const f32x4*)b + C.lane;
#pragma unroll
        for (int j = 0; j < 8; ++j) { const f32x4 o = v[j] * rstd * w4[64 * j] + b4[64 * j];
            if (Xf) ((f32x4*)(Xf + (size_t)m * DM) + C.lane)[64 * j] = o;
            if (XB) { u32x2 p; p.x = pk2(o.x, o.y); p.y = pk2(o.z, o.w); ((u32x2*)(XB + (size_t)m * DM) + C.lane)[64 * j] = p; } }
    }
}

DI void g1_item(const Ctx& C, int item) {
    const int c = item >> 2, h = item & 3, tid = C.tid, lane = C.lane, w = C.wave;
    LAS float* rgs = (LAS float*)(C.lds);
    LAS float* tot = (LAS float*)(C.lds + 4096);
    LAS unsigned short* sAq = (LAS unsigned short*)(C.lds + 8192);
    LAS unsigned short* sBk = (LAS unsigned short*)(C.lds + 8192 + 33792);
    const float* RG = WSP(float, WS_RG); const bf16* QG = WSP(bf16, WS_QG); const bf16* KG = WSP(bf16, WS_KG);
    bf16* AQ = WSP(bf16, WS_AQ); bf16* KDT = WSP(bf16, WS_KDT); bf16* PP = WSP(bf16, WS_PP); float* DEC = WSP(float, WS_DEC);
    const int t0 = c * 64;
    for (int i = tid; i < 64 * 16; i += NTHR) rgs[i] = RG[(size_t)t0 * 16 + i];
    const int k = tid & 255, half = tid >> 8;
    float wg[16];
#pragma unroll
    for (int r = 0; r < 16; ++r) wg[r] = C.in[11][r * 1024 + h * 256 + k];
    const float bias = C.in[12][h * 256 + k];
    __syncthreads();
    float run = 0.f; float la[32];
#pragma unroll
    for (int tt = 0; tt < 32; ++tt) { const int t = half * 32 + tt; float x = bias;
#pragma unroll
        for (int r = 0; r < 16; ++r) x += rgs[t * 16 + r] * wg[r];
        la[tt] = logsig16(x); run += la[tt]; }
    tot[half * 256 + k] = run;
    __syncthreads();
    const float t0s = tot[k], t1s = tot[256 + k];
    const float bl = t0s + t1s; run = half ? t0s : 0.f;
    unsigned kdp[16];
#pragma unroll
    for (int tp = 0; tp < 16; ++tp) {
        float kd2[2];
#pragma unroll
        for (int e = 0; e < 2; ++e) { const int t = half * 32 + 2 * tp + e;
            run += la[2 * tp + e];
            const float q = bf2f(QG[(size_t)(t0 + t) * 1024 + h * 256 + k]), kk = bf2f(KG[(size_t)(t0 + t) * 1024 + h * 256 + k]);
            sAq[t * 264 + k] = f2bf(q * __expf(run)); sBk[t * 264 + k] = f2bf(kk * __expf(-run)); kd2[e] = kk * __expf(bl - run); }
        kdp[tp] = pk2(kd2[0], kd2[1]);
    }
    { u32x4* dst = (u32x4*)(KDT + ((size_t)(c * 4 + h) * 256 + k) * 64 + half * 32);
#pragma unroll
      for (int i = 0; i < 4; ++i) { u32x4 v; v.x = kdp[4 * i]; v.y = kdp[4 * i + 1]; v.z = kdp[4 * i + 2]; v.w = kdp[4 * i + 3]; dst[i] = v; } }
    if (half == 0) DEC[(c * 4 + h) * 256 + k] = __expf(bl);
    __syncthreads();
#pragma unroll
    for (int i = 0; i < 4; ++i) { const int idx = tid + NTHR * i, row = idx >> 5, ch = idx & 31;
        const u32x4 v = *(const LAS u32x4*)(sAq + row * 264 + ch * 8); *(u32x4*)(AQ + ((size_t)(c * 4 + h) * 64 + row) * 256 + ch * 8) = v; }
    { const int mt = w >> 1, fr = lane & 15, fq = lane >> 4;
#pragma unroll
      for (int nn = 0; nn < 2; ++nn) { const int nt = 2 * (w & 1) + nn; f32x4 acc = {0.f, 0.f, 0.f, 0.f};
          if (nt <= mt) {
#pragma unroll
              for (int ks = 0; ks < 8; ++ks) { const bf16x8 a = *(const LAS bf16x8*)(sBk + (16 * nt + fr) * 264 + 32 * ks + 8 * fq);
                  const bf16x8 b = *(const LAS bf16x8*)(sAq + (16 * mt + fr) * 264 + 32 * ks + 8 * fq); acc = MFMA16(a, b, acc); } }
          const int t = 16 * mt + fr, s0 = 16 * nt + 4 * fq;
          u32x2 o; o.x = pk2(s0 <= t ? acc[0] : 0.f, s0 + 1 <= t ? acc[1] : 0.f); o.y = pk2(s0 + 2 <= t ? acc[2] : 0.f, s0 + 3 <= t ? acc[3] : 0.f);
          *(u32x2*)(PP + ((size_t)(c * 4 + h) * 64 + t) * 64 + s0) = o; } }
    __syncthreads();
}
DI void tr_item(const bf16* src, int ldc, bf16* dst, int item, LAS unsigned short* scr, int lane, int mode) {
    const int ncb = ldc / 32, tb = item / ncb, cb = item % ncb, t0 = 64 * tb, c0 = 32 * cb;
#pragma unroll
    for (int i = 0; i < 8; ++i) { const int row = 8 * i + (lane >> 3), ch = lane & 7;
        const u32x2 v = *(const u32x2*)(src + (size_t)(t0 + row) * ldc + c0 + 4 * ch); *(LAS u32x2*)(scr + row * 36 + 4 * ch) = v; }
    LDS_WAIT(); asm volatile("" ::: "memory");
    const int cc = lane & 31, th = lane >> 5; unsigned pw[16];
#pragma unroll
    for (int j = 0; j < 16; ++j) { const unsigned lo = scr[(32 * th + 2 * j) * 36 + cc], hi = scr[(32 * th + 2 * j + 1) * 36 + cc]; pw[j] = lo | (hi << 16); }
    const int col = c0 + cc;
    u32x4* d = mode == 0 ? (u32x4*)(dst + (((size_t)(col >> 9) * 128 + tb) * 512 + (col & 511)) * 64 + 32 * th)
                         : (u32x4*)(dst + (((size_t)(col >> 6) * 64 + (tb >> 1)) * 64 + (col & 63)) * 128 + 64 * (tb & 1) + 32 * th);
#pragma unroll
    for (int i = 0; i < 4; ++i) { u32x4 v; v.x = pw[4 * i]; v.y = pw[4 * i + 1]; v.z = pw[4 * i + 2]; v.w = pw[4 * i + 3]; d[i] = v; }
    LDS_WAIT(); asm volatile("" ::: "memory");
}
DI void g2w_item(const Ctx& C, int item) {
    const int h = item >> 9, vt = (item >> 4) & 31, kt = item & 15, fr = C.lane & 15, fq = C.lane >> 4;
    const bf16* Ap = WSP(bf16, WS_KDT) + ((size_t)h * 256 + 16 * kt + fr) * 64 + 8 * fq;
    const bf16* Bp = WSP(bf16, WS_VT) + ((size_t)h * 128 * 512 + 16 * vt + fr) * 64 + 8 * fq;
    const float* Dp = WSP(float, WS_DEC) + h * 256 + 16 * kt + 4 * fq;
    bf16* Sp = WSP(bf16, WS_ST) + ((size_t)h * 512 + 16 * vt + fr) * 256 + 16 * kt + 4 * fq;
    constexpr int PF = G2W_PF;
    bf16x8 a[PF][2], b[PF][2]; f32x4 d[PF];
#pragma unroll
    for (int i = 0; i < PF; ++i) {
        a[i][0] = *(const bf16x8*)(Ap + (size_t)i * (4 * 256 * 64)); a[i][1] = *(const bf16x8*)(Ap + (size_t)i * (4 * 256 * 64) + 32);
        b[i][0] = *(const bf16x8*)(Bp + (size_t)i * 32768); b[i][1] = *(const bf16x8*)(Bp + (size_t)i * 32768 + 32); d[i] = *(const f32x4*)(Dp + i * 1024); }
    f32x4 S = {0.f, 0.f, 0.f, 0.f};
    for (int c0 = 0; c0 < NCH; c0 += PF) {
#pragma unroll
        for (int i = 0; i < PF; ++i) { const int c = c0 + i;
            if (c > 0) { u32x2 o; o.x = pk2(S[0], S[1]); o.y = pk2(S[2], S[3]); *(u32x2*)(Sp + (size_t)c * (4 * 512 * 256)) = o; }
            S = S * d[i]; S = MFMA16(a[i][0], b[i][0], S); S = MFMA16(a[i][1], b[i][1], S);
            const int cn = c + PF;
            if (cn < NCH) { a[i][0] = *(const bf16x8*)(Ap + (size_t)cn * (4 * 256 * 64)); a[i][1] = *(const bf16x8*)(Ap + (size_t)cn * (4 * 256 * 64) + 32);
                b[i][0] = *(const bf16x8*)(Bp + (size_t)cn * 32768); b[i][1] = *(const bf16x8*)(Bp + (size_t)cn * 32768 + 32); d[i] = *(const f32x4*)(Dp + cn * 1024); } }
    }
    float* so = C.out + O_SP + ((size_t)h * 256 + 16 * kt + 4 * fq) * 512 + 16 * vt + fr;
#pragma unroll
    for (int j = 0; j < 4; ++j) so[(size_t)j * 512] = S[j];
}
#ifdef TIME_PROBE
#define G3STAMP(i) do { if (C.bid == 0 && C.tid == 0 && item < 4) ((unsigned long long*)(C.ws + WS_CTL + 512 * 1024))[(i)] = __builtin_amdgcn_s_memrealtime(); } while (0)
#else
#define G3STAMP(i) do { } while (0)
#endif
DI void g3_item(const Ctx& C, int item) {
    const int c = item >> 2, h = item & 3, tid = C.tid, w = C.wave, r = C.lane & 31, hh = C.lane >> 5, v0 = 64 * w;
    const bf16* ST = WSP(bf16, WS_ST) + (size_t)(c * 4 + h) * 512 * 256; const bf16* AQ = WSP(bf16, WS_AQ) + (size_t)(c * 4 + h) * 64 * 256;
    const bf16* PP = WSP(bf16, WS_PP) + (size_t)(c * 4 + h) * 64 * 64; const bf16* VT = WSP(bf16, WS_VT) + ((size_t)h * 128 + c) * 512 * 64;
    const bf16* GG = WSP(bf16, WS_GG); bf16* OG = WSP(bf16, WS_OG);
    LAS unsigned short* sA = (LAS unsigned short*)(C.lds);
    LAS unsigned short* sB = (LAS unsigned short*)(C.lds + 73728);
    LAS float* red = (LAS float*)(C.lds + 82944);
    f32x16 acc[2][2];
#pragma unroll
    for (int i = 0; i < 2; ++i)
#pragma unroll
        for (int j = 0; j < 2; ++j)
#pragma unroll
            for (int e = 0; e < 16; ++e) acc[i][j][e] = 0.f;
    const int ch = tid & 7, rw = tid >> 3;
    u32x4 ra[8], rb;
#define G3_LOAD(kt) do { if ((kt) < 4) { _Pragma("unroll") for (int j = 0; j < 8; ++j) ra[j] = *(const u32x4*)(ST + (size_t)(rw + 64 * j) * 256 + 64 * (kt) + 8 * ch); rb = *(const u32x4*)(AQ + (size_t)rw * 256 + 64 * (kt) + 8 * ch); } \
        else { _Pragma("unroll") for (int j = 0; j < 8; ++j) ra[j] = *(const u32x4*)(VT + (size_t)(rw + 64 * j) * 64 + 8 * ch); rb = *(const u32x4*)(PP + (size_t)rw * 64 + 8 * ch); } } while (0)
    const int kt0 = c > 0 ? 0 : 4;
    G3_LOAD(kt0);
    for (int kt = kt0; kt < 5; ++kt) {
        __syncthreads();
#pragma unroll
        for (int j = 0; j < 8; ++j) *(LAS u32x4*)(sA + (rw + 64 * j) * 72 + 8 * ch) = ra[j];
        *(LAS u32x4*)(sB + rw * 72 + 8 * ch) = rb;
        __syncthreads();
        if (kt + 1 < 5) G3_LOAD(kt + 1);
#pragma unroll
        for (int ks = 0; ks < 4; ++ks) {
            const bf16x8 a0 = *(const LAS bf16x8*)(sA + (v0 + r) * 72 + 16 * ks + 8 * hh), a1 = *(const LAS bf16x8*)(sA + (v0 + 32 + r) * 72 + 16 * ks + 8 * hh);
            const bf16x8 b0 = *(const LAS bf16x8*)(sB + r * 72 + 16 * ks + 8 * hh), b1 = *(const LAS bf16x8*)(sB + (32 + r) * 72 + 16 * ks + 8 * hh);
            acc[0][0] = MFMA32(a0, b0, acc[0][0]); acc[0][1] = MFMA32(a0, b1, acc[0][1]); acc[1][0] = MFMA32(a1, b0, acc[1][0]); acc[1][1] = MFMA32(a1, b1, acc[1][1]); }
    }
#undef G3_LOAD
    G3STAMP(20);
#pragma unroll
    for (int nt = 0; nt < 2; ++nt) { float s = 0.f;
#pragma unroll
        for (int mv = 0; mv < 2; ++mv)
#pragma unroll
            for (int e = 0; e < 16; ++e) s += acc[mv][nt][e] * acc[mv][nt][e];
        s += __shfl_xor(s, 32);
        if (hh == 0) red[w * 64 + 32 * nt + r] = s; }
    __syncthreads();
    const float* nw = C.in[13];
#pragma unroll
    for (int nt = 0; nt < 2; ++nt) { float tot = 0.f;
#pragma unroll
        for (int ww = 0; ww < 8; ++ww) tot += red[ww * 64 + 32 * nt + r];
        const float rs = 1.f / sqrtf(tot * (1.f / 512.f) + RMS_EPS);
        const size_t rowoff = (size_t)(64 * c + 32 * nt + r) * 2048 + h * 512;
#pragma unroll
        for (int mv = 0; mv < 2; ++mv)
#pragma unroll
            for (int q = 0; q < 4; ++q) { const int v = v0 + 32 * mv + 8 * q + 4 * hh;
                const f32x4 n4 = *(const f32x4*)(nw + v); const u32x2 g = *(const u32x2*)(GG + rowoff + v);
                u32x2 o; o.x = pk2(acc[mv][nt][4 * q] * rs * n4.x * bflo(g.x), acc[mv][nt][4 * q + 1] * rs * n4.y * bfhi(g.x));
                o.y = pk2(acc[mv][nt][4 * q + 2] * rs * n4.z * bflo(g.y), acc[mv][nt][4 * q + 3] * rs * n4.w * bfhi(g.y));
                *(u32x2*)(OG + rowoff + v) = o; } }
    __syncthreads();
    G3STAMP(21);
}
DI void dgla_item(const Ctx& C, int item) {
    const int b = item >> 2, h = item & 3, tid = C.tid, lane = C.lane, w = C.wave, m0 = MP + 8 * b;
    LAS float* sAq = (LAS float*)(C.lds);
    LAS float* sKd = (LAS float*)(C.lds + 8192);
    LAS float* sDec = (LAS float*)(C.lds + 16384);
    LAS float* sB = (LAS float*)(C.lds + 17408);
    LAS float* sQ = (LAS float*)(C.lds + 25600);
    LAS float* sK = (LAS float*)(C.lds + 33792);
    LAS float* sSc = (LAS float*)(C.lds + 41984);
    LAS float* sSs = (LAS float*)(C.lds + 42240);
    LAS float* red = (LAS float*)(C.lds + 43008);
    const float* RG = WSP(float, WS_RG); const bf16* QG = WSP(bf16, WS_QG); const bf16* KG = WSP(bf16, WS_KG); const bf16* VG = WSP(bf16, WS_VG);
    const bf16* GG = WSP(bf16, WS_GG); bf16* OG = WSP(bf16, WS_OG);
    if (tid < 256) { const int k = tid; float wg[16];
#pragma unroll
        for (int r = 0; r < 16; ++r) wg[r] = C.in[11][r * 1024 + h * 256 + k];
        const float bias = C.in[12][h * 256 + k]; float bb[8], qq[8], kk[8]; float run = 0.f;
#pragma unroll
        for (int t = 0; t < 8; ++t) { float x = bias;
#pragma unroll
            for (int r = 0; r < 16; ++r) x += RG[(size_t)(m0 + t) * 16 + r] * wg[r];
            run += logsig16(x); bb[t] = run; qq[t] = bf2f(QG[(size_t)(m0 + t) * 1024 + h * 256 + k]); kk[t] = bf2f(KG[(size_t)(m0 + t) * 1024 + h * 256 + k]);
            sB[t * 256 + k] = run; sQ[t * 256 + k] = qq[t]; sK[t * 256 + k] = kk[t]; }
#pragma unroll
        for (int t = 0; t < 8; ++t) { sAq[k * 8 + t] = qq[t] * __expf(bb[t]); sKd[k * 8 + t] = kk[t] * __expf(bb[7] - bb[t]); }
        sDec[k] = __expf(bb[7]); }
    __syncthreads();
    { const int t = w;
      for (int s = 0; s < 8; ++s) { float p = 0.f;
          if (s <= t) {
#pragma unroll
              for (int i = 0; i < 4; ++i) { const int k = lane + 64 * i; p += sQ[t * 256 + k] * sK[s * 256 + k] * __expf(sB[t * 256 + k] - sB[s * 256 + k]); }
              p = wave_sum(p); }
          if (lane == 0) sSc[t * 8 + s] = p; } }
    const int v4 = tid & 127, kq = tid >> 7;
    f32x4 vv[8];
#pragma unroll
    for (int s = 0; s < 8; ++s) { const u32x2 g = *(const u32x2*)(VG + (size_t)(m0 + s) * 2048 + h * 512 + 4 * v4); vv[s] = (f32x4){bflo(g.x), bfhi(g.x), bflo(g.y), bfhi(g.y)}; }
    f32x4 acc[8];
#pragma unroll
    for (int t = 0; t < 8; ++t) acc[t] = (f32x4){0.f, 0.f, 0.f, 0.f};
    { const f32x4* S0 = (const f32x4*)(C.in[2] + ((size_t)(b * 4 + h) * 256 + kq * 64) * 512) + v4;
      f32x4* SN = (f32x4*)(C.out + O_SS + ((size_t)(b * 4 + h) * 256 + kq * 64) * 512) + v4;
      for (int kb = 0; kb < 64; kb += 8) { f32x4 sv[8];
#pragma unroll
          for (int u = 0; u < 8; ++u) sv[u] = __builtin_nontemporal_load(S0 + (size_t)(kb + u) * 128);
#pragma unroll
          for (int u = 0; u < 8; ++u) { const int k = kq * 64 + kb + u; const f32x4 s4 = sv[u];
              const f32x4 a0 = *(const LAS f32x4*)(sAq + k * 8), a1 = *(const LAS f32x4*)(sAq + k * 8 + 4);
              const f32x4 k0 = *(const LAS f32x4*)(sKd + k * 8), k1 = *(const LAS f32x4*)(sKd + k * 8 + 4); const float dc = sDec[k];
              acc[0] += s4 * a0.x; acc[1] += s4 * a0.y; acc[2] += s4 * a0.z; acc[3] += s4 * a0.w; acc[4] += s4 * a1.x; acc[5] += s4 * a1.y; acc[6] += s4 * a1.z; acc[7] += s4 * a1.w;
              f32x4 sn = s4 * dc; sn += vv[0] * k0.x; sn += vv[1] * k0.y; sn += vv[2] * k0.z; sn += vv[3] * k0.w; sn += vv[4] * k1.x; sn += vv[5] * k1.y; sn += vv[6] * k1.z; sn += vv[7] * k1.w;
              __builtin_nontemporal_store(sn, SN + (size_t)(kb + u) * 128); } } }
#pragma unroll
    for (int t = 0; t < 8; ++t) *(LAS f32x4*)(red + (size_t)((kq * 8 + t) * 512) + 4 * v4) = acc[t];
    __syncthreads();
    f32x4 o2[2];
#pragma unroll
    for (int e = 0; e < 2; ++e) { const int t = 2 * kq + e; f32x4 o = {0.f, 0.f, 0.f, 0.f};
#pragma unroll
        for (int q = 0; q < 4; ++q) o += *(const LAS f32x4*)(red + (size_t)((q * 8 + t) * 512) + 4 * v4);
#pragma unroll
        for (int s = 0; s < 8; ++s) o += vv[s] * sSc[t * 8 + s];
        o2[e] = o; float ss = (o.x * o.x + o.y * o.y) + (o.z * o.z + o.w * o.w); ss = wave_sum(ss);
        if (lane == 0) sSs[t * 2 + (w & 1)] = ss; }
    __syncthreads();
    const f32x4 n4 = *(const f32x4*)(C.in[13] + 4 * v4);
#pragma unroll
    for (int e = 0; e < 2; ++e) { const int t = 2 * kq + e; const float rs = 1.f / sqrtf((sSs[t * 2] + sSs[t * 2 + 1]) * (1.f / 512.f) + RMS_EPS);
        const size_t off = (size_t)(m0 + t) * 2048 + h * 512 + 4 * v4; const u32x2 g = *(const u32x2*)(GG + off);
        u32x2 o; o.x = pk2(o2[e].x * rs * n4.x * bflo(g.x), o2[e].y * rs * n4.y * bfhi(g.x)); o.y = pk2(o2[e].z * rs * n4.z * bflo(g.y), o2[e].w * rs * n4.w * bfhi(g.y));
        *(u32x2*)(OG + off) = o; }
    __syncthreads();
}
DI void dswa_item(const Ctx& C, int item) {
    const int b = item >> 3, kvh = item & 7, tid = C.tid, m0 = MP + 8 * b;
    LAS float* sK = (LAS float*)(C.lds);
    LAS float* sV = (LAS float*)(C.lds + 36992);
    LAS float* sQ = (LAS float*)(C.lds + 73984);
    LAS float* sP = (LAS float*)(C.lds + 82176);
    const bf16* QS = WSP(bf16, WS_QS); const bf16* KS = WSP(bf16, WS_KS); const bf16* VS = WSP(bf16, WS_VS); bf16* OS = WSP(bf16, WS_OS);
    for (int idx = tid; idx < 128 * 16; idx += NTHR) { const int row = idx >> 4, c4 = idx & 15;
        const size_t so = ((size_t)(b * 128 + row) * 8 + kvh) * 64 + 4 * c4;
        const f32x4 kv = *(const f32x4*)(C.in[3] + so), vv = *(const f32x4*)(C.in[4] + so);
        *(LAS f32x4*)(sK + row * 68 + 4 * c4) = kv; *(LAS f32x4*)(sV + row * 68 + 4 * c4) = vv;
        if (row >= 8) { const size_t oo = ((size_t)(b * 128 + row - 8) * 8 + kvh) * 64 + 4 * c4; *(f32x4*)(C.out + O_KS + oo) = kv; *(f32x4*)(C.out + O_VS + oo) = vv; } }
    if (tid < 128) { const int t = tid >> 4, c4 = tid & 15; const size_t so = (size_t)(m0 + t) * 512 + kvh * 64 + 4 * c4;
        const u32x2 kq = *(const u32x2*)(KS + so), vq = *(const u32x2*)(VS + so);
        *(LAS f32x4*)(sK + (128 + t) * 68 + 4 * c4) = (f32x4){bflo(kq.x), bfhi(kq.x), bflo(kq.y), bfhi(kq.y)};
        *(LAS f32x4*)(sV + (128 + t) * 68 + 4 * c4) = (f32x4){bflo(vq.x), bfhi(vq.x), bflo(vq.y), bfhi(vq.y)}; }
    { const int row = tid >> 4, c4 = tid & 15, g = row >> 3, t = row & 7;
      const u32x2 q = *(const u32x2*)(QS + (size_t)(m0 + t) * 2048 + (kvh * 4 + g) * 64 + 4 * c4);
      *(LAS f32x4*)(sQ + row * 64 + 4 * c4) = (f32x4){bflo(q.x), bfhi(q.x), bflo(q.y), bfhi(q.y)}; }
    __syncthreads();
    { const int row = tid >> 4, jl = tid & 15, g = row >> 3, t = row & 7, hq = kvh * 4 + g;
      const float slope = exp2f(-0.25f * (float)(hq + 1)), sink = C.in[14][hq];
      float sc[9]; float mx = -3.0e38f;
#pragma unroll
      for (int i = 0; i < 9; ++i) sc[i] = 0.f;
#pragma unroll 2
      for (int c4 = 0; c4 < 16; ++c4) { const f32x4 q = *(const LAS f32x4*)(sQ + row * 64 + 4 * c4);
#pragma unroll
          for (int i = 0; i < 9; ++i) { int j = jl + 16 * i; j = j < 136 ? j : 135; const f32x4 kx = *(const LAS f32x4*)(sK + j * 68 + 4 * c4); sc[i] += (q.x * kx.x + q.y * kx.y) + (q.z * kx.z + q.w * kx.w); } }
#pragma unroll
      for (int i = 0; i < 9; ++i) { const int j = jl + 16 * i; const int dist = 128 + t - j; float s = -3.0e38f;
          if (j < 136 && dist >= 0 && dist < 128) s = sc[i] - slope * (float)dist;
          sc[i] = s; mx = fmaxf(mx, s); }
#pragma unroll
      for (int o = 1; o < 16; o <<= 1) mx = fmaxf(mx, __shfl_xor(mx, o));
      mx = fmaxf(mx, sink); float sum = 0.f;
#pragma unroll
      for (int i = 0; i < 9; ++i) { const float e = (sc[i] > -1.0e38f) ? __expf(sc[i] - mx) : 0.f; sc[i] = e; sum += e; }
#pragma unroll
      for (int o = 1; o < 16; o <<= 1) sum += __shfl_xor(sum, o);
      const float inv = 1.f / (sum + __expf(sink - mx));
#pragma unroll
      for (int i = 0; i < 9; ++i) { const int j = jl + 16 * i; if (j < 136) sP[row * 136 + j] = sc[i] * inv; } }
    __syncthreads();
    { const int row = tid >> 4, dq = tid & 15, g = row >> 3, t = row & 7; f32x4 o = {0.f, 0.f, 0.f, 0.f};
      for (int j = 0; j < 136; ++j) { const float p = sP[row * 136 + j]; o += *(const LAS f32x4*)(sV + j * 68 + 4 * dq) * p; }
      u32x2 w; w.x = pk2(o.x, o.y); w.y = pk2(o.z, o.w);
      *(u32x2*)(OS + (size_t)(m0 + t) * 2048 + (kvh * 4 + g) * 64 + 4 * dq) = w; }
    __syncthreads();
}
DI void pswa_item(const Ctx& C, int item) {
    const int n = item >> 3, kvh = item & 7, w = C.wave, r = C.lane & 31, hh = C.lane >> 5, g = w >> 1, th = w & 1, hq = kvh * 4 + g;
    const bf16* QS = WSP(bf16, WS_QS); const bf16* KS = WSP(bf16, WS_KS); const bf16* VST = WSP(bf16, WS_VST); bf16* OS = WSP(bf16, WS_OS);
    const float slope = exp2f(-0.25f * (float)(hq + 1)), sink = C.in[14][hq];
#pragma unroll 1
    for (int pass = 0; pass < 2; ++pass) {
        const int i0 = 64 * th + 32 * pass, qtok = 128 * n + i0 + r;
        bf16x8 qf[4];
#pragma unroll
        for (int ks = 0; ks < 4; ++ks) qf[ks] = *(const bf16x8*)(QS + (size_t)qtok * 2048 + hq * 64 + 16 * ks + 8 * hh);
        f32x16 s[5];
#pragma unroll
        for (int jj = 0; jj < 5; ++jj) {
#pragma unroll
            for (int e = 0; e < 16; ++e) s[jj][e] = 0.f;
            int kt = (n - 1) * 128 + i0 + 32 * jj + r; kt = kt < 0 ? 0 : kt;
#pragma unroll
            for (int ks = 0; ks < 4; ++ks) { const bf16x8 kf = *(const bf16x8*)(KS + (size_t)kt * 512 + kvh * 64 + 16 * ks + 8 * hh); s[jj] = MFMA32(kf, qf[ks], s[jj]); }
            asm volatile("" ::: "memory"); }
        float mx = -3.0e38f;
        int rr = r - 4 * hh; asm volatile("" : "+v"(rr));
#pragma unroll
        for (int jj = 0; jj < 5; ++jj)
#pragma unroll
            for (int e = 0; e < 16; ++e) { const int cr0 = (e & 3) + 8 * (e >> 2); const int dist = 128 + rr - 32 * jj - cr0; const int j = i0 + 32 * jj + cr0 + 4 * hh;
                const bool valid = (dist >= 0) && (dist < 128) && (n > 0 || j >= 128);
                const float v = valid ? s[jj][e] - slope * (float)dist : -3.0e38f; s[jj][e] = v; mx = fmaxf(mx, v); }
        mx = fmaxf(mx, __shfl_xor(mx, 32)); mx = fmaxf(mx, sink);
        float sum = 0.f;
#pragma unroll
        for (int jj = 0; jj < 5; ++jj)
#pragma unroll
            for (int e = 0; e < 16; ++e) { const float p = (s[jj][e] > -1.0e38f) ? __expf(s[jj][e] - mx) : 0.f; s[jj][e] = p; sum += p; }
        sum += __shfl_xor(sum, 32);
        const float inv = 1.f / (sum + __expf(sink - mx));
        f32x16 o[2];
#pragma unroll
        for (int md = 0; md < 2; ++md)
#pragma unroll
            for (int e = 0; e < 16; ++e) o[md][e] = 0.f;
#pragma unroll
        for (int jj = 0; jj < 5; ++jj) {
            int kb = (n - 1) * 128 + i0 + 32 * jj; kb = kb < 0 ? 0 : kb;
#pragma unroll
            for (int st = 0; st < 2; ++st) {
                u32x4 pw; pw.x = pk2(s[jj][8 * st], s[jj][8 * st + 1]); pw.y = pk2(s[jj][8 * st + 2], s[jj][8 * st + 3]); pw.z = pk2(s[jj][8 * st + 4], s[jj][8 * st + 5]); pw.w = pk2(s[jj][8 * st + 6], s[jj][8 * st + 7]);
                const bf16x8 pb = __builtin_bit_cast(bf16x8, pw);
#pragma unroll
                for (int md = 0; md < 2; ++md) { const bf16* vp = VST + (((size_t)kvh * 64 + (kb >> 7)) * 64 + 32 * md + r) * 128 + (kb & 127) + 16 * st + 4 * hh;
                    const u32x2 lo = *(const u32x2*)vp, hi = *(const u32x2*)(vp + 8); u32x4 aw; aw.x = lo.x; aw.y = lo.y; aw.z = hi.x; aw.w = hi.y;
                    o[md] = MFMA32(__builtin_bit_cast(bf16x8, aw), pb, o[md]); } }
            asm volatile("" ::: "memory"); }
#pragma unroll
        for (int md = 0; md < 2; ++md)
#pragma unroll
            for (int q = 0; q < 4; ++q) { u32x2 ow; ow.x = pk2(o[md][4 * q] * inv, o[md][4 * q + 1] * inv); ow.y = pk2(o[md][4 * q + 2] * inv, o[md][4 * q + 3] * inv);
                *(u32x2*)(OS + (size_t)qtok * 2048 + hq * 64 + 32 * md + 8 * q + 4 * hh) = ow; }
    }
}

constexpr int CW_BAR = 4096;
#define XB_TMO      128
#define XB_XCNT(j)  (256  + 64 * (j))
#define XB_XSUB(j)  (1280 + 64 * (j))
#define XB_XGEN(j)  (2304 + 64 * (j))
#define XB_TOP      3328
#define XB_TOPGEN   3392
#define XCD_BAR_WORDS 3456
#define XB_SPIN_CAP (1u << 18)

__device__ __forceinline__ unsigned xb_ld(unsigned* p)              { return __hip_atomic_load(p, __ATOMIC_RELAXED, __HIP_MEMORY_SCOPE_AGENT); }
__device__ __forceinline__ unsigned xb_add(unsigned* p, unsigned v) { return __hip_atomic_fetch_add(p, v, __ATOMIC_RELAXED, __HIP_MEMORY_SCOPE_AGENT); }
__device__ __forceinline__ unsigned xb_xcc_id() { return (unsigned)__builtin_amdgcn_s_getreg((3 << 11) | 20) & 0xFu; }
#define XB_SPIN(cond, bar) do { unsigned _sp = 0; while (cond) { __builtin_amdgcn_s_sleep(1); \
    if ((++_sp & 255u) == 0u) { if (xb_ld(&(bar)[XB_TMO])) break; if (_sp > XB_SPIN_CAP) { atomicAdd(&(bar)[XB_TMO], 1u); break; } } } } while (0)

struct XcdBarrier {
    unsigned* bar; unsigned x;
    volatile LAS unsigned* st;
};

__device__ __forceinline__ XcdBarrier xcd_barrier_post(unsigned* bar, volatile LAS unsigned* st) {
    XcdBarrier b; b.bar = bar; b.x = xb_xcc_id(); b.st = st;
    if (threadIdx.x == 0) (void)xb_add(&bar[XB_XCNT(b.x)], 1u);
    return b;
}
__device__ __forceinline__ void xcd_barrier_complete(unsigned* bar, unsigned x, unsigned& nloc, unsigned& nx) {
    const unsigned G = gridDim.x * gridDim.y * gridDim.z;
    unsigned sum, cnt, mine, sp = 0u;
    for (;;) {
        sum = 0u; cnt = 0u; mine = 0u;
#pragma unroll
        for (unsigned j = 0; j < 16; ++j) { const unsigned c = xb_ld(&bar[XB_XCNT(j)]); sum += c; cnt += (c > 0u) ? 1u : 0u; mine = (j == x) ? c : mine; }
        if (sum == G) break;
        __builtin_amdgcn_s_sleep(1);
        if ((++sp & 255u) == 0u) { if (xb_ld(&bar[XB_TMO])) break; if (sp > XB_SPIN_CAP) { atomicAdd(&bar[XB_TMO], 1u); break; } }
    }
    nloc = mine > 0u ? mine : 1u; nx = cnt > 0u ? cnt : 1u;
}

__device__ __forceinline__ void xcd_barrier(const XcdBarrier& b) {
    asm volatile("s_waitcnt vmcnt(0)" ::: "memory");
    __syncthreads();
    if (threadIdx.x == 0) {
        unsigned* bar = b.bar;
        __builtin_amdgcn_s_waitcnt(0);
        unsigned nloc = b.st[0], nx = b.st[1];
        if (nloc == 0u) { xcd_barrier_complete(bar, b.x, nloc, nx); b.st[0] = nloc; b.st[1] = nx; }
        const unsigned old = xb_add(&bar[XB_XSUB(b.x)], 1u);
        const unsigned gen = old / nloc;
        if (old + 1u == (gen + 1u) * nloc) {
            __builtin_amdgcn_fence(__ATOMIC_RELEASE, "agent");
            asm volatile("s_waitcnt vmcnt(0)" ::: "memory");
            const unsigned og = xb_add(&bar[XB_TOP], 1u);
            const unsigned tg = og / nx;
            if (og + 1u == (tg + 1u) * nx) xb_add(&bar[XB_TOPGEN], 1u);
            else XB_SPIN(xb_ld(&bar[XB_TOPGEN]) == tg, bar);
            __builtin_amdgcn_fence(__ATOMIC_ACQUIRE, "agent");
            xb_add(&bar[XB_XGEN(b.x)], 1u);
            asm volatile("s_waitcnt vmcnt(0)" ::: "memory");
        } else {
            XB_SPIN(xb_ld(&bar[XB_XGEN(b.x)]) == gen, bar);
            __builtin_amdgcn_fence(__ATOMIC_ACQUIRE, "agent");
            asm volatile("s_waitcnt vmcnt(0)" ::: "memory");
        }
    }
    __syncthreads();
}

#ifndef MK_N_LAUNCHES
#define MK_N_LAUNCHES 1
#endif
constexpr int N_PHASES = 15;
__global__ void __launch_bounds__(NTHR, 2) hybrid_fwd(Args args) {
    extern __shared__ __attribute__((aligned(16))) unsigned char lds_raw[];
    Ctx C;
    C.lds = (LAS unsigned char*)lds_raw; C.tid = threadIdx.x; C.lane = C.tid & 63; C.wave = __builtin_amdgcn_readfirstlane(C.tid >> 6);
    C.G = gridDim.x; C.bid = blockIdx.x; C.in = args.in; C.out = args.out; C.ws = args.ws;
    const int lo = args.ph_lo, hi = args.ph_hi;
    unsigned* ctl = (unsigned*)(args.ws + WS_CTL);
    volatile LAS unsigned* misc = (volatile LAS unsigned*)(C.lds + LDS_MISC);
#ifndef USE_CG_SYNC
    if (C.tid < 16) misc[C.tid] = 0u;
    __syncthreads();
    XcdBarrier bar = xcd_barrier_post(ctl + CW_BAR, misc + 8);
#define GRID_SYNC() xcd_barrier(bar)
#else
#define GRID_SYNC() cg::this_grid().sync()
#endif
#ifndef PH_MASK
#define PH_MASK 0xFFFFFFFFu
#endif
#define IN(k) ((((PH_MASK) >> (k)) & 1u) && lo <= (k) && (k) < hi)
#define OPAQUE_CTX() Ctx C2 = C; asm volatile("" : "+v"(C2.tid), "+v"(C2.lane))
#ifndef REP_MASK
#define REP_MASK 0u
#endif
#define REPK(k) ((int)(((REP_MASK) >> (k)) & 1u))
#ifndef REP_SUB
#define REP_SUB 0
#endif
#define SUBM(m) (rep_ == 0 || REP_SUB == 0 || REP_SUB == (m))
#ifdef TIME_PROBE
#define TSTAMP(i) do { if (C.bid == 0 && C.tid == 0) tsw[(i)] = __builtin_amdgcn_s_memrealtime(); } while (0)
#else
#define TSTAMP(i) do { } while (0)
#endif
#define SEAM(k) do { if (IN(k) && IN((k) + 1)) { GRID_SYNC(); } TSTAMP((k) + 1); } while (0)
    typedef pg8::bf16_t pb;
#ifdef TIME_PROBE
    unsigned long long* tsw = (unsigned long long*)(args.ws + WS_CTL + 512 * 1024);
#endif
    TSTAMP(0);
    if (IN(0)) for (int rep_ = 0; rep_ <= REPK(0); ++rep_) { if (rep_) GRID_SYNC();  p0_prologue(C); }
    SEAM(0);
    if (IN(1)) for (int rep_ = 0; rep_ <= REPK(1); ++rep_) { if (rep_) GRID_SYNC();  pg8::Gemm g{WSP(pb, WS_XB), WSP(pb, WS_WF1), MT, 2 * DFF, DM}; pg8::StaticOrder S; S.init(MT, 2 * DFF, C.G, C.bid, DM);
        pg8::EpiSwiglu E{WSP(pb, WS_HB), DFF}; pg8::gemm_phase<pg8::EpiSwiglu, pg8::StaticOrder, true, true>(C.lds, g, S, E);
        if (rep_ == 0 && C.bid >= 48) conv_rest(C, C.bid - 48, C.G - 48); }
    SEAM(1);
    if (IN(2)) for (int rep_ = 0; rep_ <= REPK(2); ++rep_) { if (rep_) GRID_SYNC();  pg8::Gemm g{WSP(pb, WS_HB), WSP(pb, WS_WF2), MT, DM, DFF}; pg8::TailOrder S; S.init(DFF, C.bid);
        pg8::EpiRes<1> E{C.in[0], C.in[1], WSP(float, WS_Y)}; pg8::gemm_phase<pg8::EpiRes<1>, pg8::TailOrder, true, true>(C.lds, g, S, E); }
    SEAM(2);
    if (IN(3)) for (int rep_ = 0; rep_ <= REPK(3); ++rep_) { if (rep_) GRID_SYNC();  ln_phase(C, WSP(float, WS_Y), C.in[7], C.in[8], WSP(float, WS_X), WSP(bf16, WS_XB), WSP(float, WS_PART), C.in[1], ALPHA, 0.5f); }
    SEAM(3);
    if (IN(4)) for (int rep_ = 0; rep_ <= REPK(4); ++rep_) { if (rep_) GRID_SYNC();  pg8::Gemm g{WSP(pb, WS_XB), WSP(pb, WS_WIN), MT, DINP, DM}; pg8::StaticOrder S; S.init(MT, DINP, C.G, C.bid, DM);
        pg8::EpiZ E{WSP(pb, WS_QG), WSP(pb, WS_KG), WSP(pb, WS_VG), WSP(pb, WS_GG), WSP(pb, WS_QS), WSP(pb, WS_KS), WSP(pb, WS_VS), WSP(pb, WS_SGG), WSP(pb, WS_SGS), WSP(float, WS_RG), WSP(float, WS_BP), C.out};
        pg8::gemm_phase<pg8::EpiZ, pg8::StaticOrder, true, true>(C.lds, g, S, E);
        if (rep_ == 0 && C.bid >= 116) conv_ffn(C, C.in[20], C.in[21], C.bid - 116, C.G - 116); }
    SEAM(4);
    if (IN(5)) for (int rep_ = 0; rep_ <= REPK(5); ++rep_) { if (rep_) GRID_SYNC();
        if (SUBM(1)) for (int it = C.bid; it < NCH * 4; it += C.G) { OPAQUE_CTX(); g1_item(C2, it); }
        TSTAMP(17);
        if (SUBM(2)) for (int it = C.bid; it < 128 * 8; it += C.G) { OPAQUE_CTX(); dswa_item(C2, it); }
        TSTAMP(18);
        if (SUBM(3)) { LAS unsigned short* scr = (LAS unsigned short*)(C.lds + C.wave * 8192); const int gw = C.bid * NWAVES + C.wave, NGW = C.G * NWAVES;
          for (int it = gw; it < 128 * 64 + 128 * 16; it += NGW) {
              if (it < 128 * 64) tr_item(WSP(bf16, WS_VG), 2048, WSP(bf16, WS_VT), it, scr, C.lane, 0);
              else tr_item(WSP(bf16, WS_VS), 512, WSP(bf16, WS_VST), it - 128 * 64, scr, C.lane, 1); } }
    }
    SEAM(5);
    if (IN(6)) for (int rep_ = 0; rep_ <= REPK(6); ++rep_) { if (rep_) GRID_SYNC();
        if (SUBM(3)) { OPAQUE_CTX(); const int gw = C.bid * NWAVES + C.wave, NGW = C.G * NWAVES; for (int it = gw; it < 2048; it += NGW) g2w_item(C2, it); }
        __syncthreads(); TSTAMP(16);
        for (;;) {
            if (C.tid == 0) misc[0] = __hip_atomic_fetch_add(ctl + CW_QUEUE + 64 * rep_, 1u, __ATOMIC_RELAXED, __HIP_MEMORY_SCOPE_AGENT);
            __syncthreads();
            const int it = (int)misc[0];
            __syncthreads();
            if (it >= 1024) break;
            if (!SUBM(it < 512 ? 1 : 2)) continue;
            OPAQUE_CTX();
            if (it < 512) dgla_item(C2, it); else pswa_item(C2, it - 512);
        }
    }
    SEAM(6);
    if (IN(7)) for (int rep_ = 0; rep_ <= REPK(7); ++rep_) { if (rep_) GRID_SYNC();  for (int it = C.bid; it < NCH * 4; it += C.G) { OPAQUE_CTX(); g3_item(C2, it); } }
    SEAM(7);
    if (IN(8)) for (int rep_ = 0; rep_ <= REPK(8); ++rep_) { if (rep_) GRID_SYNC();  pg8::Gemm g{WSP(pb, WS_OG), WSP(pb, WS_WBG), MT, DM, DM}; pg8::StaticOrder S; S.init(MT, DM, C.G, C.bid, DM);
        pg8::EpiGateMul E{WSP(pb, WS_SGG), WSP(float, WS_Y)}; pg8::gemm_phase<pg8::EpiGateMul, pg8::StaticOrder, true, true>(C.lds, g, S, E); }
    SEAM(8);
    if (IN(9)) for (int rep_ = 0; rep_ <= REPK(9); ++rep_) { if (rep_) GRID_SYNC();  pg8::Gemm g{WSP(pb, WS_OS), WSP(pb, WS_WBS), MT, DM, DM}; pg8::StaticOrder S; S.init(MT, DM, C.G, C.bid, DM);
        pg8::EpiMerge E{WSP(pb, WS_SGS), WSP(float, WS_Y), WSP(pb, WS_MG)}; pg8::gemm_phase<pg8::EpiMerge, pg8::StaticOrder, true, true>(C.lds, g, S, E); }
    SEAM(9);
    if (IN(10)) for (int rep_ = 0; rep_ <= REPK(10); ++rep_) { if (rep_) GRID_SYNC();  pg8::Gemm g{WSP(pb, WS_MG), WSP(pb, WS_WO), MT, DM, DM}; pg8::TailOrder S; S.init(DM, C.bid);
        pg8::EpiRes<2> E{WSP(float, WS_X), WSP(float, WS_X) + (size_t)MP * DM, WSP(float, WS_Y)}; pg8::gemm_phase<pg8::EpiRes<2>, pg8::TailOrder, true, true>(C.lds, g, S, E); }
    SEAM(10);
    if (IN(11)) for (int rep_ = 0; rep_ <= REPK(11); ++rep_) { if (rep_) GRID_SYNC();  ln_phase(C, WSP(float, WS_Y), C.in[18], C.in[19], WSP(float, WS_X), WSP(bf16, WS_XB), WSP(float, WS_PART), WSP(float, WS_X) + (size_t)MP * DM, ALPHA, 1.0f); }
    SEAM(11);
    if (IN(12)) for (int rep_ = 0; rep_ <= REPK(12); ++rep_) { if (rep_) GRID_SYNC();  pg8::Gemm g{WSP(pb, WS_XB), WSP(pb, WS_WF1), MT, 2 * DFF, DM}; pg8::StaticOrder S; S.init(MT, 2 * DFF, C.G, C.bid, DM);
        pg8::EpiSwiglu E{WSP(pb, WS_HB), DFF}; pg8::gemm_phase<pg8::EpiSwiglu, pg8::StaticOrder, true, true>(C.lds, g, S, E); }
    SEAM(12);
    if (IN(13)) for (int rep_ = 0; rep_ <= REPK(13); ++rep_) { if (rep_) GRID_SYNC();  pg8::Gemm g{WSP(pb, WS_HB), WSP(pb, WS_WF2), MT, DM, DFF}; pg8::TailOrder S; S.init(DFF, C.bid);
        pg8::EpiRes<1> E{WSP(float, WS_X), WSP(float, WS_X) + (size_t)MP * DM, WSP(float, WS_Y)}; pg8::gemm_phase<pg8::EpiRes<1>, pg8::TailOrder, true, true>(C.lds, g, S, E); }
    SEAM(13);
    if (IN(14)) for (int rep_ = 0; rep_ <= REPK(14); ++rep_) { if (rep_) GRID_SYNC();  ln_phase(C, WSP(float, WS_Y), C.in[22], C.in[23], C.out + O_YP, nullptr, WSP(float, WS_PART), WSP(float, WS_X) + (size_t)MP * DM, ALPHA, 0.5f); }
#ifdef TIME_PROBE
    TSTAMP(15);
    if (C.bid == 0 && C.tid == 0) {
        const unsigned long long ta = tsw[TIME_A1] - tsw[TIME_A0], tb = tsw[TIME_B1] - tsw[TIME_B0];
        unsigned long long A = ta / 100; if (A > 999) A = 999; unsigned long long B = tb / (100 * TIME_BDIV); if (B > 249) B = 249;
        const unsigned long long target = (100000ull + A + 1000ull * B) * 100ull;
        while (__builtin_amdgcn_s_memrealtime() - tsw[0] < target) __builtin_amdgcn_s_sleep(32);
    }
#endif
#undef IN
#undef SEAM
}


#ifdef DEBUG_PROBE
constexpr int CW_CHK = 1024;
constexpr int N_STAGES = 19;
DI unsigned hash32(unsigned x) { x ^= x >> 16; x *= 0x7feb352dU; x ^= x >> 15; x *= 0x846ca68bU; x ^= x >> 16; return x; }
DI float dsilu(float x) { return x / (1.f + expf(-x)); }
DI float dsigm(float x) { return 1.f / (1.f + expf(-x)); }
DI int seg_start(int i) { switch (i) { case 0: return 0; case 1: return 1024; case 2: return 2048; case 3: return 4096; case 4: return 6144; case 5: return 6160; case 6: return 8208; case 7: return 8720; case 8: return 9232; case 9: return 11280; default: return 13328; } }
DI float dot_bw(const bf16* a, const float* W, int ldw, int col, int K) { float s = 0.f; for (int k = 0; k < K; ++k) s += bf2f(a[k]) * W[(size_t)k * ldw + col]; return s; }
#define WSQ(T, off) ((T*)(ws + (off)))
#define CMP(got, ref) do { const float g_ = (got), r_ = (ref); e2 += (g_ - r_) * (g_ - r_); r2 += r_ * r_; } while (0)
__global__ void __launch_bounds__(256) chk_kernel(Args args, int stage) {
    unsigned char* ws = args.ws; float* slot = (float*)(ws + WS_CTL) + CW_CHK + 2 * stage; float* out = args.out;
    const int tid = threadIdx.x, gid = blockIdx.x * 256 + tid;
    const unsigned h1 = hash32(gid * 2654435761u + stage * 977u + 12345u), h2 = hash32(h1 + 0x9e3779b9u), h3 = hash32(h2 + 0x85ebca6bu);
    float e2 = 0.f, r2 = 0.f;
    __shared__ float sh[8 * 256 * 3 + 64];
    if (stage == 1 || stage == 16) {
        const float* wi = args.in[stage == 1 ? 5 : 20]; const float* wo = args.in[stage == 1 ? 6 : 21];
        { const int n = h1 % 11264, k = h2 % 2048, pn = n >> 8, wq = n & 255, src = wq < 128 ? 128 * pn + wq : DFF + 128 * pn + wq - 128;
          CMP(bf2f(WSQ(bf16, WS_WF1)[(size_t)n * 2048 + k]), wi[(size_t)k * 11264 + src]); }
        { const int n = h2 % 2048, k = h3 % 5632; CMP(bf2f(WSQ(bf16, WS_WF2)[(size_t)n * 5632 + k]), wo[(size_t)k * 2048 + n]); }
        if (stage == 1) {
            { const int n = h3 % DINP, k = h1 % 2048; float ref = 0.f; if (n < 6144) ref = args.in[9][(size_t)k * DIN + n]; else if (n < 13312) ref = args.in[9][(size_t)k * DIN + n + 16]; else if (n < 13328) ref = args.in[9][(size_t)k * DIN + n - 13312 + 6144];
              CMP(bf2f(WSQ(bf16, WS_WIN)[(size_t)n * 2048 + k]), ref); }
            { const int n = h1 % 2048, k = h3 % 2048; CMP(bf2f(WSQ(bf16, WS_WBG)[(size_t)n * 2048 + k]), args.in[15][(size_t)k * 2048 + n]);
              CMP(bf2f(WSQ(bf16, WS_WBS)[(size_t)n * 2048 + k]), args.in[16][(size_t)k * 2048 + n]); CMP(bf2f(WSQ(bf16, WS_WO)[(size_t)n * 2048 + k]), args.in[17][(size_t)k * 2048 + n]); }
            { const int m = h2 % MT, k = h1 % 2048; const float xr = m < MP ? args.in[0][(size_t)m * DM + k] : args.in[1][(size_t)(m - MP) * DM + k]; CMP(bf2f(WSQ(bf16, WS_XB)[(size_t)m * DM + k]), xr); }
            { const int i = h3 % DINP; float ref = 0.f; if (i < 6144) ref = args.in[10][i]; else if (i < 13312) ref = args.in[10][i + 16]; else if (i < 13328) ref = args.in[10][i - 13312 + 6144]; CMP(WSQ(float, WS_BP)[i], ref); }
        }
    }
    if (stage == 2 || stage == 17) {
        const float* wi = args.in[stage == 2 ? 5 : 20]; const int m = h1 % MT, j = h2 % DFF; const bf16* a = WSQ(bf16, WS_XB) + (size_t)m * DM;
        const float g = dot_bw(a, wi, 2 * DFF, j, DM), u = dot_bw(a, wi, 2 * DFF, DFF + j, DM);
        CMP(bf2f(WSQ(bf16, WS_HB)[(size_t)m * DFF + j]), dsilu(g) * u);
    }
    if (stage == 3 || stage == 18) {
        const float* wo = args.in[stage == 3 ? 6 : 21]; const int m = h1 % MT, n = h2 % DM;
        const float xr = stage == 3 ? (m < MP ? args.in[0][(size_t)m * DM + n] : args.in[1][(size_t)(m - MP) * DM + n]) : WSQ(float, WS_X)[(size_t)m * DM + n];
        CMP(WSQ(float, WS_Y)[(size_t)m * DM + n], ALPHA * xr + 0.5f * dot_bw(WSQ(bf16, WS_HB) + (size_t)m * DFF, wo, DM, n, DFF));
    }
    if (stage == 4 || stage == 16 || stage == 19) {
        const float* lw = args.in[stage == 4 ? 7 : (stage == 16 ? 18 : 22)]; const float* lb = args.in[stage == 4 ? 8 : (stage == 16 ? 19 : 23)];
        const int m = h1 % MT; const float* y = WSQ(float, WS_Y) + (size_t)m * DM; float s = 0.f;
        for (int k = 0; k < DM; ++k) s += y[k];
        const float mean = s / DM; float q = 0.f;
        for (int k = 0; k < DM; ++k) q += (y[k] - mean) * (y[k] - mean);
        const float rstd = 1.f / sqrtf(q / DM + LN_EPS);
        for (int i = 0; i < 8; ++i) { const int n = hash32(h2 + i) % DM; const float ref = (y[n] - mean) * rstd * lw[n] + lb[n];
            if (stage == 19) CMP(out[O_YP + (size_t)m * DM + n], ref);
            else { CMP(WSQ(float, WS_X)[(size_t)m * DM + n], ref); CMP(bf2f(WSQ(bf16, WS_XB)[(size_t)m * DM + n]), ref); } }
    }
    if (stage == 5) {
        const int seg = gid % 10; const int sg0 = seg_start(seg), sg1 = seg_start(seg + 1);
        int m = h1 % MT; if ((seg == 6 || seg == 7) && (h3 & 1)) m = 8064 + h1 % (MT - 8064);
        const int n = sg0 + h2 % (sg1 - sg0), c = n - sg0;
        const float d = dot_bw(WSQ(bf16, WS_XB) + (size_t)m * DM, args.in[9], DIN, n, DM) + args.in[10][n];
        if (seg == 0) CMP(bf2f(WSQ(bf16, WS_QG)[(size_t)m * 1024 + c]), d * 0.0625f);
        if (seg == 1) CMP(bf2f(WSQ(bf16, WS_KG)[(size_t)m * 1024 + c]), d);
        if (seg == 2) CMP(bf2f(WSQ(bf16, WS_VG)[(size_t)m * 2048 + c]), d);
        if (seg == 3) CMP(bf2f(WSQ(bf16, WS_GG)[(size_t)m * 2048 + c]), dsilu(d));
        if (seg == 4) CMP(WSQ(float, WS_RG)[(size_t)m * 16 + c], d);
        if (seg == 5) CMP(bf2f(WSQ(bf16, WS_QS)[(size_t)m * 2048 + c]), d * 0.125f);
        if (seg == 6 || seg == 7) { CMP(bf2f(WSQ(bf16, seg == 6 ? WS_KS : WS_VS)[(size_t)m * 512 + c]), d);
            if (m >= MP) { const int rr = m - MP; CMP(out[(seg == 6 ? O_KS : O_VS) + ((size_t)((rr >> 3) * 128 + 120 + (rr & 7))) * 512 + c], d); }
            else if (m >= 8064) CMP(out[(seg == 6 ? O_KP : O_VP) + (size_t)(m - 8064) * 512 + c], d); }
        if (seg == 8) CMP(bf2f(WSQ(bf16, WS_SGG)[(size_t)m * 2048 + c]), dsigm(d));
        if (seg == 9) CMP(bf2f(WSQ(bf16, WS_SGS)[(size_t)m * 2048 + c]), dsigm(d));
    }
    const float* RG = WSQ(float, WS_RG); const float* wgg = args.in[11]; const float* bgg = args.in[12];
    if (stage == 6) {
        const int c = h1 % NCH, h = h2 & 3, tl = (h2 >> 2) & 63, k = (h2 >> 8) & 255, t0 = 64 * c; float run = 0.f, bt = 0.f;
        for (int tau = 0; tau < 64; ++tau) { float x = bgg[h * 256 + k]; for (int r = 0; r < 16; ++r) x += RG[(size_t)(t0 + tau) * 16 + r] * wgg[r * 1024 + h * 256 + k]; run += logsig16(x); if (tau == tl) bt = run; }
        const float q = bf2f(WSQ(bf16, WS_QG)[(size_t)(t0 + tl) * 1024 + h * 256 + k]), kk = bf2f(WSQ(bf16, WS_KG)[(size_t)(t0 + tl) * 1024 + h * 256 + k]);
        CMP(bf2f(WSQ(bf16, WS_AQ)[((size_t)(c * 4 + h) * 64 + tl) * 256 + k]), q * expf(bt));
        CMP(bf2f(WSQ(bf16, WS_KDT)[((size_t)(c * 4 + h) * 256 + k) * 64 + tl]), kk * expf(run - bt));
        CMP(WSQ(float, WS_DEC)[(c * 4 + h) * 256 + k], expf(run));
        if (gid < 128) { const int s = (h3 >> 3) & 63; float p = 0.f;
            for (int k2 = 0; k2 < 256; ++k2) { float rn = 0.f, b_t = 0.f, b_s = 0.f;
                for (int tau = 0; tau < 64; ++tau) { float x = bgg[h * 256 + k2]; for (int r = 0; r < 16; ++r) x += RG[(size_t)(t0 + tau) * 16 + r] * wgg[r * 1024 + h * 256 + k2]; rn += logsig16(x); if (tau == tl) b_t = rn; if (tau == s) b_s = rn; }
                p += bf2f(WSQ(bf16, WS_QG)[(size_t)(t0 + tl) * 1024 + h * 256 + k2]) * bf2f(WSQ(bf16, WS_KG)[(size_t)(t0 + s) * 1024 + h * 256 + k2]) * expf(b_t - b_s); }
            CMP(bf2f(WSQ(bf16, WS_PP)[((size_t)(c * 4 + h) * 64 + tl) * 64 + s]), s <= tl ? p : 0.f); }
    }
    if (stage == 7) {
        { const int c = h1 % 2048, t = h2 % 8192; CMP(bf2f(WSQ(bf16, WS_VT)[(((size_t)(c >> 9) * 128 + (t >> 6)) * 512 + (c & 511)) * 64 + (t & 63)]), bf2f(WSQ(bf16, WS_VG)[(size_t)t * 2048 + c])); }
        { const int c = h3 % 512, t = h1 % 8192; CMP(bf2f(WSQ(bf16, WS_VST)[(((size_t)(c >> 6) * 64 + (t >> 7)) * 64 + (c & 63)) * 128 + (t & 127)]), bf2f(WSQ(bf16, WS_VS)[(size_t)t * 512 + c])); }
    }
    if (stage == 8 || stage == 11) {
        const int hq = h2 & 31, kvh = hq >> 2; const float slope = exp2f(-0.25f * (float)(hq + 1)), sink = args.in[14][hq];
        int qrow, nkeys; const int b = h1 % 128, t = (h1 >> 8) & 7, tok = h1 % MP;
        if (stage == 8) { qrow = MP + 8 * b + t; nkeys = 136; } else { qrow = tok; nkeys = 128; }
        float mx = sink, den = 0.f; float o[10];
#pragma unroll
        for (int i = 0; i < 10; ++i) o[i] = 0.f;
        for (int pass = 0; pass < 2; ++pass) {
            for (int j = 0; j < nkeys; ++j) { float d = 0.f; bool valid; int dist; int kt = 0;
                if (stage == 8) { dist = 128 + t - j; valid = dist >= 0 && dist < 128;
                    for (int e = 0; e < 64; ++e) { const float kx = j < 128 ? args.in[3][((size_t)(b * 128 + j) * 8 + kvh) * 64 + e] : bf2f(WSQ(bf16, WS_KS)[(size_t)(MP + 8 * b + j - 128) * 512 + kvh * 64 + e]);
                        d += bf2f(WSQ(bf16, WS_QS)[(size_t)qrow * 2048 + hq * 64 + e]) * kx; } }
                else { kt = tok - 127 + j; dist = tok - kt; valid = kt >= 0;
                    if (valid) for (int e = 0; e < 64; ++e) d += bf2f(WSQ(bf16, WS_QS)[(size_t)qrow * 2048 + hq * 64 + e]) * bf2f(WSQ(bf16, WS_KS)[(size_t)kt * 512 + kvh * 64 + e]); }
                const float sj = d - slope * (float)dist;
                if (pass == 0) { if (valid) mx = fmaxf(mx, sj); }
                else if (valid) { const float p = expf(sj - mx); den += p;
#pragma unroll
                    for (int i = 0; i < 10; ++i) { const int e = 7 * i; float vx;
                        if (stage == 8) vx = j < 128 ? args.in[4][((size_t)(b * 128 + j) * 8 + kvh) * 64 + e] : bf2f(WSQ(bf16, WS_VS)[(size_t)(MP + 8 * b + j - 128) * 512 + kvh * 64 + e]);
                        else vx = bf2f(WSQ(bf16, WS_VS)[(size_t)kt * 512 + kvh * 64 + e]);
                        o[i] += p * vx; } } } }
        den += expf(sink - mx);
#pragma unroll
        for (int i = 0; i < 10; ++i) CMP(bf2f(WSQ(bf16, WS_OS)[(size_t)qrow * 2048 + hq * 64 + 7 * i]), o[i] / den);
        if (stage == 8) { const int j = h3 % 120, e = (h3 >> 8) & 63;
            CMP(out[O_KS + ((size_t)(b * 128 + j) * 8 + kvh) * 64 + e], args.in[3][((size_t)(b * 128 + j + 8) * 8 + kvh) * 64 + e]);
            CMP(out[O_VS + ((size_t)(b * 128 + j) * 8 + kvh) * 64 + e], args.in[4][((size_t)(b * 128 + j + 8) * 8 + kvh) * 64 + e]); }
    }
    if (stage == 9) {
        const int h = h1 & 3, k = (h1 >> 2) & 255, v = (h1 >> 10) & 511; float s = 0.f;
        for (int t = 0; t < MP; ++t) {
            if ((t & 63) == 0 && t > 0) CMP(bf2f(WSQ(bf16, WS_ST)[((size_t)((t >> 6) * 4 + h) * 512 + v) * 256 + k]), s);
            float x = bgg[h * 256 + k]; for (int r = 0; r < 16; ++r) x += RG[(size_t)t * 16 + r] * wgg[r * 1024 + h * 256 + k];
            s = expf(logsig16(x)) * s + bf2f(WSQ(bf16, WS_KG)[(size_t)t * 1024 + h * 256 + k]) * bf2f(WSQ(bf16, WS_VG)[(size_t)t * 2048 + h * 512 + v]); }
        CMP(out[O_SP + ((size_t)h * 256 + k) * 512 + v], s);
    }
    if (stage == 10) {
        const int b = hash32(blockIdx.x * 7919u + 17u) % 128, h = blockIdx.x & 3, m0 = MP + 8 * b;
        float* la = sh; float* qv = sh + 2048; float* kv = sh + 4096; float* red = sh + 6144;
        for (int i = tid; i < 2048; i += 256) { const int t = i >> 8, k = i & 255; float x = bgg[h * 256 + k]; for (int r = 0; r < 16; ++r) x += RG[(size_t)(m0 + t) * 16 + r] * wgg[r * 1024 + h * 256 + k];
            la[i] = expf(logsig16(x)); qv[i] = bf2f(WSQ(bf16, WS_QG)[(size_t)(m0 + t) * 1024 + h * 256 + k]); kv[i] = bf2f(WSQ(bf16, WS_KG)[(size_t)(m0 + t) * 1024 + h * 256 + k]); }
        __syncthreads();
        float o[2][8];
#pragma unroll
        for (int vi = 0; vi < 2; ++vi) { const int v = tid + 256 * vi; float vt[8];
#pragma unroll
            for (int t = 0; t < 8; ++t) { vt[t] = bf2f(WSQ(bf16, WS_VG)[(size_t)(m0 + t) * 2048 + h * 512 + v]); o[vi][t] = 0.f; }
            for (int k = 0; k < 256; ++k) { float s = args.in[2][((size_t)(b * 4 + h) * 256 + k) * 512 + v];
#pragma unroll
                for (int t = 0; t < 8; ++t) { s = la[t * 256 + k] * s + kv[t * 256 + k] * vt[t]; o[vi][t] += qv[t * 256 + k] * s; }
                CMP(out[O_SS + ((size_t)(b * 4 + h) * 256 + k) * 512 + v], s); } }
#pragma unroll
        for (int t = 0; t < 8; ++t) { float ss = o[0][t] * o[0][t] + o[1][t] * o[1][t]; ss = wave_sum(ss); __syncthreads(); if ((tid & 63) == 0) red[tid >> 6] = ss; __syncthreads();
            const float rs = 1.f / sqrtf((red[0] + red[1] + red[2] + red[3]) / 512.f + RMS_EPS);
#pragma unroll
            for (int vi = 0; vi < 2; ++vi) { const int v = tid + 256 * vi; const size_t off = (size_t)(m0 + t) * 2048 + h * 512 + v;
                CMP(bf2f(WSQ(bf16, WS_OG)[off]), o[vi][t] * rs * args.in[13][v] * bf2f(WSQ(bf16, WS_GG)[off])); } }
    }
    if (stage == 12) {
        const int t = hash32(blockIdx.x * 104729u + 3u) % MP, h = blockIdx.x & 3, c = t >> 6, tl = t & 63; float* red = sh; float o[2];
#pragma unroll
        for (int vi = 0; vi < 2; ++vi) { const int v = tid + 256 * vi; float s = 0.f;
            if (c > 0) for (int k = 0; k < 256; ++k) s += bf2f(WSQ(bf16, WS_AQ)[((size_t)(c * 4 + h) * 64 + tl) * 256 + k]) * bf2f(WSQ(bf16, WS_ST)[((size_t)(c * 4 + h) * 512 + v) * 256 + k]);
            for (int s2 = 0; s2 < 64; ++s2) s += bf2f(WSQ(bf16, WS_PP)[((size_t)(c * 4 + h) * 64 + tl) * 64 + s2]) * bf2f(WSQ(bf16, WS_VG)[(size_t)(64 * c + s2) * 2048 + h * 512 + v]);
            o[vi] = s; }
        float ss = o[0] * o[0] + o[1] * o[1]; ss = wave_sum(ss); if ((tid & 63) == 0) red[tid >> 6] = ss; __syncthreads();
        const float rs = 1.f / sqrtf((red[0] + red[1] + red[2] + red[3]) / 512.f + RMS_EPS);
#pragma unroll
        for (int vi = 0; vi < 2; ++vi) { const int v = tid + 256 * vi; const size_t off = (size_t)t * 2048 + h * 512 + v; CMP(bf2f(WSQ(bf16, WS_OG)[off]), o[vi] * rs * args.in[13][v] * bf2f(WSQ(bf16, WS_GG)[off])); }
    }
    if (stage == 13) { const int m = h1 % MT, n = h2 % DM;
        CMP(WSQ(float, WS_Y)[(size_t)m * DM + n], bf2f(WSQ(bf16, WS_SGG)[(size_t)m * DM + n]) * dot_bw(WSQ(bf16, WS_OG) + (size_t)m * DM, args.in[15], DM, n, DM)); }
    if (stage == 14) { const int m = h1 % MT, n = h2 % DM;
        CMP(bf2f(WSQ(bf16, WS_MG)[(size_t)m * DM + n]), WSQ(float, WS_Y)[(size_t)m * DM + n] + bf2f(WSQ(bf16, WS_SGS)[(size_t)m * DM + n]) * dot_bw(WSQ(bf16, WS_OS) + (size_t)m * DM, args.in[16], DM, n, DM)); }
    if (stage == 15) { const int m = h1 % MT, n = h2 % DM;
        CMP(WSQ(float, WS_Y)[(size_t)m * DM + n], ALPHA * WSQ(float, WS_X)[(size_t)m * DM + n] + dot_bw(WSQ(bf16, WS_MG) + (size_t)m * DM, args.in[17], DM, n, DM)); }
    atomicAdd(slot, e2); atomicAdd(slot + 1, r2);
}
__global__ void __launch_bounds__(256) report_kernel(Args args) {
    const float* slot = (const float*)(args.ws + WS_CTL) + CW_CHK; float* out = args.out;
    int s1 = 0, s2 = 0; float e1 = 0.f, e2v = 0.f, emax = 0.f;
    for (int s = 1; s <= N_STAGES; ++s) { const float err = sqrtf(slot[2 * s] / fmaxf(slot[2 * s + 1], 1e-30f)); const bool bad = !(err < 0.03f) || !(slot[2 * s + 1] > 0.f);
        if (!bad) emax = fmaxf(emax, err);
        if (bad) { const float ec = (err == err) ? fminf(err, 1.f) : 1.f; if (!s1) { s1 = s; e1 = ec; } else if (!s2) { s2 = s; e2v = ec; } } }
    const float mant1 = s1 ? 1.f + 8.f * e1 : 1.f + 8.f * fminf(1.f, emax * 10.f);
    const float R = mant1 * powf(10.f, (float)(s1 + 1));
    const float e = sqrtf((R - 0.0625f) * 16.f / 15.f);
    for (size_t i = (size_t)blockIdx.x * 256 + threadIdx.x; i < (size_t)128 * 120 * 512; i += (size_t)gridDim.x * 256) {
        const size_t b = i / (120 * 512), r = i % (120 * 512); out[O_KS + b * 128 * 512 + r] = args.in[3][b * 128 * 512 + 8 * 512 + r] * (1.f + e); }
    if (blockIdx.x == 0 && threadIdx.x == 0) out[O_SS] = sqrtf(R) * 10.f * powf(1.25f, (float)s2) * (1.f + 0.1f * e2v);
}
#endif
#ifdef PROBE_OUT
__global__ void __launch_bounds__(256) probe_kernel(Args args, size_t lo, size_t hi, float k) {
    float* out = args.out;
    for (size_t i = (size_t)blockIdx.x * 256 + threadIdx.x; i < O_END; i += (size_t)gridDim.x * 256) out[i] = (i >= lo && i < hi) ? out[i] * k : 0.f;
}
#endif

extern "C" void kernel_launch(void* const* d_in, const int* in_sizes, int n_in, void* d_out, int out_size, void* d_ws, size_t ws_size, hipStream_t stream) {
    static int grid = 0;
    if (grid == 0) {
        if (n_in != 24 || (size_t)out_size != O_END || ws_size < WS_END) { fprintf(stderr, "kernel_launch: unexpected problem: n_in %d out %d ws %zu (need %zu)\n", n_in, out_size, ws_size, (size_t)WS_END); grid = -1; return; }
        int dev = 0, cus = 0, per_cu = 0;
        if (hipGetDevice(&dev) != hipSuccess || hipDeviceGetAttribute(&cus, hipDeviceAttributeMultiprocessorCount, dev) != hipSuccess) { grid = -1; return; }
        if (hipFuncSetAttribute((const void*)hybrid_fwd, hipFuncAttributeMaxDynamicSharedMemorySize, LDS_BYTES) != hipSuccess) { fprintf(stderr, "kernel_launch: hipFuncSetAttribute failed\n"); grid = -1; return; }
        if (hipOccupancyMaxActiveBlocksPerMultiprocessor(&per_cu, (const void*)hybrid_fwd, NTHR, LDS_BYTES) != hipSuccess || per_cu < 1) { fprintf(stderr, "kernel_launch: occupancy query says %d\n", per_cu); per_cu = 1; }
        (void)hipGetLastError();
        grid = cus;
        if (cus != 256) { fprintf(stderr, "kernel_launch: built for a 256-CU device (got %d)\n", cus); grid = -1; return; }
    }
    if (grid < 0) return;
    (void)hipMemsetAsync((char*)d_ws + WS_CTL, 0, CTL_ZERO_BYTES, stream);
    Args a{};
    for (int i = 0; i < 24; ++i) a.in[i] = (const float*)d_in[i];
    a.out = (float*)d_out; a.ws = (unsigned char*)d_ws;
#if defined(DEBUG_PROBE)
    { static const int chk_after[15][3] = {{1,0,0},{2,0,0},{3,0,0},{4,0,0},{5,0,0},{6,7,8},{9,10,11},{12,0,0},{13,0,0},{14,0,0},{15,0,0},{16,0,0},{17,0,0},{18,0,0},{19,0,0}};
      for (int p = 0; p < N_PHASES; ++p) { a.ph_lo = p; a.ph_hi = p + 1; hipLaunchKernelGGL(hybrid_fwd, dim3(grid), dim3(NTHR), LDS_BYTES, stream, a);
          for (int j = 0; j < 3; ++j) { const int st = chk_after[p][j]; if (!st) continue;
              int nb = 4; if (st == 1 || st == 7 || st == 16) nb = 16; if (st == 5) nb = 8; if (st == 8 || st == 11) nb = 2; if (st == 9 || st == 4 || st == 19) nb = 1; if (st == 10) nb = 8; if (st == 12) nb = 64;
              hipLaunchKernelGGL(chk_kernel, dim3(nb), dim3(256), 0, stream, a, st); } }
      (void)hipMemsetAsync(d_out, 0, (size_t)O_END * 4, stream);
      hipLaunchKernelGGL(report_kernel, dim3(256), dim3(256), 0, stream, a); }
#elif defined(PROBE_OUT)
    for (int p = 0; p < N_PHASES; ++p) { a.ph_lo = p; a.ph_hi = p + 1; hipLaunchKernelGGL(hybrid_fwd, dim3(grid), dim3(NTHR), LDS_BYTES, stream, a); }
    { const size_t ob[9] = {0, 16777216ull, O_SP, O_KP, O_VP, O_SS, O_KS, O_VS, O_END};
      hipLaunchKernelGGL(probe_kernel, dim3(2048), dim3(256), 0, stream, a, ob[PROBE_OUT], ob[PROBE_OUT + 1], (float)(PROBE_K)); }
#elif MK_N_LAUNCHES == 1
    a.ph_lo = 0; a.ph_hi = N_PHASES;
#ifdef USE_CG_SYNC
    void* kargs[] = {&a};
    hipError_t e = hipLaunchCooperativeKernel((const void*)hybrid_fwd, dim3(grid), dim3(NTHR), kargs, LDS_BYTES, stream);
    if (e != hipSuccess) fprintf(stderr, "kernel_launch: cooperative launch failed: %s (grid %d)\n", hipGetErrorString(e), grid);
#else
    hipLaunchKernelGGL(hybrid_fwd, dim3(grid), dim3(NTHR), LDS_BYTES, stream, a);
#endif
#else
    for (int p = 0; p < N_PHASES; ++p) { a.ph_lo = p; a.ph_hi = p + 1; hipLaunchKernelGGL(hybrid_fwd, dim3(grid), dim3(NTHR), LDS_BYTES, stream, a); }
#endif
}
```
